# Optimizing an MI355X kernel written in HIP

```python
import math
import jax, jax.numpy as jnp
from jax import lax
import numpy as np

D_MODEL = 1024
BATCH = 8
SEQ = 8192
DEPTH = 1

BRANCH_W = D_MODEL
N_BRANCH = 3
LRU_W = BRANCH_W
LRU_BLOCKS = 16
LRU_BLOCK_W = LRU_W // LRU_BLOCKS
LRU_C = 8.0
CONV_W = 4
FOX_HEAD_DIM = 64
FOX_HEADS = BRANCH_W // FOX_HEAD_DIM
FOX_W = FOX_HEADS * FOX_HEAD_DIM
Q_BLOCK = 128
MEM_LEN = 256
MEM_HEADS = 4
MEM_HEAD_DIM = BRANCH_W // MEM_HEADS
MEM_W = MEM_HEADS * MEM_HEAD_DIM
RMS_EPS = 1e-6
NEG_INF = -1e30
SPLIT_SIZES = (LRU_W, LRU_W, FOX_W, FOX_W, FOX_W, FOX_HEADS, FOX_W, MEM_W, MEM_W, N_BRANCH * D_MODEL)
IN_COLS = sum(SPLIT_SIZES)

kernel_name = "hybrid_rglru_fox_memxattn_gated_merge"


def rmsnorm(x, g):
    xf = x.astype(jnp.float32)
    y = xf * lax.rsqrt(jnp.mean(xf * xf, axis=-1, keepdims=True) + RMS_EPS)
    return (y * g.astype(jnp.float32)).astype(x.dtype)


def causal_depthwise_conv(u, w, b):
    C = u.shape[-1]
    out = lax.conv_general_dilated(
        u, w.reshape(CONV_W, 1, C).astype(u.dtype),
        window_strides=(1,), padding=[(CONV_W - 1, 0)],
        dimension_numbers=("NWC", "WIO", "NWC"), feature_group_count=C)
    return out + b.astype(u.dtype)


def rg_lru(xc, w_r, b_r, w_i, b_i, lam):
    B, S, W = xc.shape
    xg = xc.reshape(B, S, LRU_BLOCKS, LRU_BLOCK_W)
    r = jax.nn.sigmoid(jnp.einsum("bsgi,gij->bsgj", xg, w_r) + b_r).reshape(B, S, W)
    i = jax.nn.sigmoid(jnp.einsum("bsgi,gij->bsgj", xg, w_i) + b_i).reshape(B, S, W)
    log_a = (-LRU_C * r.astype(jnp.float32)) * jax.nn.softplus(-lam.astype(jnp.float32))
    a = jnp.exp(log_a)
    mult = jnp.sqrt(-jnp.expm1(2.0 * log_a))
    u = mult * (i * xc).astype(jnp.float32)

    def combine(left, right):
        a1, b1 = left
        a2, b2 = right
        return a1 * a2, a2 * b1 + b2

    _, h = lax.associative_scan(combine, (a, u), axis=1)
    return h.astype(xc.dtype)


def forgetting_attention(q, k, v, log_f):
    B, S, H, Dh = q.shape
    nb = S // Q_BLOCK
    scale = 1.0 / math.sqrt(Dh)
    c = jnp.cumsum(log_f, axis=1)
    c_k = jnp.transpose(c, (0, 2, 1))
    kf = k.astype(jnp.float32)
    vf = v.astype(jnp.float32)
    qb = jnp.transpose(q.reshape(B, nb, Q_BLOCK, H, Dh), (1, 0, 2, 3, 4))
    cb = jnp.transpose(c.reshape(B, nb, Q_BLOCK, H), (1, 0, 3, 2))
    kpos = jnp.arange(S)

    def one_block(args):
        blk, qi, ci = args
        s = jnp.einsum("bqhd,bkhd->bhqk", qi.astype(jnp.float32), kf) * scale
        s = s + (ci[..., :, None] - c_k[..., None, :])
        qpos = blk * Q_BLOCK + jnp.arange(Q_BLOCK)
        mask = kpos[None, :] <= qpos[:, None]
        s = jnp.where(mask, s, NEG_INF)
        p = jax.nn.softmax(s, axis=-1)
        return jnp.einsum("bhqk,bkhd->bqhd", p, vf)

    o = lax.map(one_block, (jnp.arange(nb), qb, cb))
    return jnp.transpose(o, (1, 0, 2, 3, 4)).reshape(B, S, H, Dh).astype(q.dtype)


def memory_attention(qm, mk, mv):
    scale = 1.0 / math.sqrt(qm.shape[-1])
    s = jnp.einsum("bshd,bmhd->bhsm", qm.astype(jnp.float32), mk.astype(jnp.float32)) * scale
    p = jax.nn.softmax(s, axis=-1)
    o = jnp.einsum("bhsm,bmhd->bshd", p, mv.astype(jnp.float32))
    return o.astype(qm.dtype)


def setup_inputs(seed: int = 0) -> dict:
    key = jax.random.key(seed)
    ks = jax.random.split(key, 20)
    f32 = jnp.float32
    x = jax.random.normal(ks[0], (BATCH, SEQ, D_MODEL), f32)
    mem = jax.random.normal(ks[1], (BATCH, MEM_LEN, D_MODEL), f32)
    g_pre = 1.0 + 0.1 * jax.random.normal(ks[2], (D_MODEL,), f32)
    w_in = jax.random.normal(ks[3], (D_MODEL, IN_COLS), f32) * D_MODEL ** -0.5
    conv_w = jax.random.normal(ks[4], (CONV_W, LRU_W), f32) * CONV_W ** -0.5
    conv_b = 0.02 * jax.random.normal(ks[5], (LRU_W,), f32)
    w_lru_r = jax.random.normal(ks[6], (LRU_BLOCKS, LRU_BLOCK_W, LRU_BLOCK_W), f32) * LRU_BLOCK_W ** -0.5
    b_lru_r = 0.02 * jax.random.normal(ks[7], (LRU_BLOCKS, LRU_BLOCK_W), f32)
    w_lru_i = jax.random.normal(ks[8], (LRU_BLOCKS, LRU_BLOCK_W, LRU_BLOCK_W), f32) * LRU_BLOCK_W ** -0.5
    b_lru_i = 0.02 * jax.random.normal(ks[9], (LRU_BLOCKS, LRU_BLOCK_W), f32)
    a0 = jax.random.uniform(ks[10], (LRU_W,), f32, minval=0.9, maxval=0.999)
    lru_lambda = jnp.log(a0) - jnp.log1p(-a0)
    b_forget = 3.0 + 0.5 * jax.random.normal(ks[11], (FOX_HEADS,), f32)
    g_mem = 1.0 + 0.1 * jax.random.normal(ks[12], (D_MODEL,), f32)
    w_mem_k = jax.random.normal(ks[13], (D_MODEL, MEM_W), f32) * D_MODEL ** -0.5
    w_mem_v = jax.random.normal(ks[14], (D_MODEL, MEM_W), f32) * D_MODEL ** -0.5
    w_branch = jax.random.normal(ks[15], (N_BRANCH, BRANCH_W, D_MODEL), f32) * BRANCH_W ** -0.5
    b_merge = 0.02 * jax.random.normal(ks[16], (N_BRANCH, D_MODEL), f32)
    w_out = jax.random.normal(ks[17], (D_MODEL, D_MODEL), f32) * D_MODEL ** -0.5
    g_post = 1.0 + 0.1 * jax.random.normal(ks[18], (D_MODEL,), f32)
    return {"x": x, "mem": mem, "g_pre": g_pre, "w_in": w_in, "conv_w": conv_w, "conv_b": conv_b,
            "w_lru_r": w_lru_r, "b_lru_r": b_lru_r, "w_lru_i": w_lru_i, "b_lru_i": b_lru_i,
            "lru_lambda": lru_lambda, "b_forget": b_forget, "g_mem": g_mem, "w_mem_k": w_mem_k,
            "w_mem_v": w_mem_v, "w_branch": w_branch, "b_merge": b_merge, "w_out": w_out,
            "g_post": g_post}


def hybrid_layer(x, mem, g_pre, w_in, conv_w, conv_b, w_lru_r, b_lru_r, w_lru_i, b_lru_i,
                 lru_lambda, b_forget, g_mem, w_mem_k, w_mem_v, w_branch, b_merge, w_out, g_post):
    B, S, D = x.shape
    Bm, M, _ = mem.shape
    xn = rmsnorm(x, g_pre)
    z = xn @ w_in
    offsets = [int(o) for o in np.cumsum(SPLIT_SIZES)[:-1]]
    (a_x, a_gate, f_q, f_k, f_v, f_logit, f_gate, m_q, m_gate, merge_logit) = jnp.split(z, offsets, axis=-1)

    xc = causal_depthwise_conv(a_x, conv_w, conv_b)
    h = rg_lru(xc, w_lru_r, b_lru_r, w_lru_i, b_lru_i, lru_lambda)
    y_a = h * jax.nn.silu(a_gate)

    q = f_q.reshape(B, S, FOX_HEADS, FOX_HEAD_DIM)
    k = f_k.reshape(B, S, FOX_HEADS, FOX_HEAD_DIM)
    v = f_v.reshape(B, S, FOX_HEADS, FOX_HEAD_DIM)
    log_f = jax.nn.log_sigmoid((f_logit + b_forget).astype(jnp.float32))
    o_b = forgetting_attention(q, k, v, log_f)
    y_b = o_b.reshape(B, S, FOX_W) * jax.nn.silu(f_gate)

    mn = rmsnorm(mem, g_mem)
    mk = (mn @ w_mem_k).reshape(Bm, M, MEM_HEADS, MEM_HEAD_DIM)
    mv = (mn @ w_mem_v).reshape(Bm, M, MEM_HEADS, MEM_HEAD_DIM)
    o_m = memory_attention(m_q.reshape(B, S, MEM_HEADS, MEM_HEAD_DIM), mk, mv)
    y_m = o_m.reshape(B, S, MEM_W) * jax.nn.silu(m_gate)

    ys = jnp.stack([y_a, y_b, y_m], axis=2)
    proj = jnp.einsum("bsnw,nwd->bsnd", ys, w_branch)
    gates = jax.nn.sigmoid(merge_logit.reshape(B, S, N_BRANCH, D) + b_merge)
    merged = jnp.sum(gates * proj, axis=2)
    out = merged @ w_out
    return x + rmsnorm(out, g_post)


def reference(x, mem, g_pre, w_in, conv_w, conv_b, w_lru_r, b_lru_r, w_lru_i, b_lru_i,
              lru_lambda, b_forget, g_mem, w_mem_k, w_mem_v, w_branch, b_merge, w_out, g_post):
    h = x
    for _ in range(DEPTH):
        h = hybrid_layer(h, mem, g_pre, w_in, conv_w, conv_b, w_lru_r, b_lru_r, w_lru_i, b_lru_i,
                         lru_lambda, b_forget, g_mem, w_mem_k, w_mem_v, w_branch, b_merge, w_out, g_post)
    return h
```

```cpp
#include <hip/hip_runtime.h>
#include <hip/hip_cooperative_groups.h>
#include <hip/hip_bf16.h>
#include <cstdio>
#include <cstdint>
#include <cmath>
namespace cg = cooperative_groups;

constexpr int NB = 8, T = 8192, D = 1024, MTOK = NB * T;
constexpr int CHB = 2, MC = CHB * T, NCHUNK = NB / CHB;
constexpr int IN_COLS = 11280;
constexpr int LDZ = 11264, NZT = 44, NIN = 11520;
constexpr int ZC_AX = 0, ZC_GA = 1024, ZC_Q = 2048, ZC_K = 3072, ZC_V = 4096, ZC_GF = 5120, ZC_MQ = 6144, ZC_GM = 7168, ZC_MG = 8192;
constexpr int MEMLEN = 256;
constexpr float RMS_EPS = 1e-6f;
constexpr float LOG2E = 1.4426950408889634f;

namespace pg8 {
#define PG8_LAS __attribute__((address_space(3)))
typedef unsigned short bf16_t;
typedef short bf16x8 __attribute__((ext_vector_type(8)));
typedef float f32x4 __attribute__((ext_vector_type(4)));
typedef unsigned u32x4 __attribute__((ext_vector_type(4)));
constexpr int BM = 256, BK = 64, HALF = 128, HTB = HALF * BK * 2, STAGE_BYTES = 8 * HTB, NXCD = 8, WGM = 8;

__host__ __device__ __forceinline__ int lds_byte(int r, int c) { const int st = (r >> 4) * 2 + (c >> 5), rr = r & 15, cc = c & 31, ob = rr * 64 + cc * 2; return st * 1024 + (ob ^ (((ob >> 9) & 1) << 5)); }
__host__ __device__ __forceinline__ void stage_rc(int b, int& R, int& C) { const int st = b / 1024, sb = b % 1024, swz = sb ^ (((sb >> 9) & 1) << 5); R = (st >> 1) * 16 + swz / 64; C = (st & 1) * 32 + (swz % 64) / 2; }
__host__ __device__ __forceinline__ int perm32(int rho) { const int n = rho >> 4, i = rho & 15; return 8 * (i >> 2) + 4 * n + (i & 3); }

struct Unit { int pm, pn, z, ldo; const bf16_t* A; const bf16_t* B; bf16_t* O; const bf16_t* G; };
struct Gemm { int lda, ldb, K; };

struct TileOrder {
    int nM, nN, nwg, G, c;
    __device__ __forceinline__ void init(int nM_, int nN_, int G_, int c_) { nM = nM_; nN = nN_; nwg = nM * nN; G = G_; c = c_; }
    __device__ __forceinline__ bool map(int i, int& pm, int& pn) const {
        const long L = (long)i * G + c; if (L >= nwg) return false;
        int wgid = (int)L; { const int q = nwg / NXCD, r = nwg % NXCD, xcd = wgid % NXCD, off = wgid / NXCD; wgid = (xcd < r ? xcd * (q + 1) : r * (q + 1) + (xcd - r) * q) + off; }
        const int nig = WGM * nN, gid = wgid / nig, fm = gid * WGM, gsz = (nM - fm) < WGM ? (nM - fm) : WGM;
        pm = fm + ((wgid % nig) % gsz); pn = (wgid % nig) / gsz; return true;
    }
};

__device__ __forceinline__ unsigned cvt_pk_bf16(float lo, float hi) { unsigned r; asm volatile("v_cvt_pk_bf16_f32 %0, %1, %2" : "=v"(r) : "v"(lo), "v"(hi)); return r; }
__device__ __forceinline__ float bf_lo(unsigned w) { return __builtin_bit_cast(float, w << 16); }
__device__ __forceinline__ float bf_hi(unsigned w) { return __builtin_bit_cast(float, w & 0xffff0000u); }
__device__ __forceinline__ float sigm(float x) { return __builtin_amdgcn_rcpf(1.f + __expf(-x)); }

template <class Epi, class Sched>
__device__ __forceinline__ void gemm_phase(PG8_LAS unsigned char* lds, const Gemm g, const Sched& S, const Epi& E) {
    int tid_ = threadIdx.x; asm volatile("" : "+v"(tid_));
    const int tid = tid_, wid = __builtin_amdgcn_readfirstlane(tid >> 6), lane = tid & 63, wr = wid >> 2, wc = wid & 3, fr = lane & 15, fq = lane >> 4;
    const int K = g.K, nt = K / BK;
    unsigned voffA[2], voffB[2];
#pragma unroll
    for (int i = 0; i < 2; ++i) { int R, C; stage_rc(tid * 16 + i * 8192, R, C); const int Rb = (R & ~31) + perm32(R & 31);
        voffA[i] = (unsigned)(R * g.lda + C) * 2u; voffB[i] = (unsigned)(Rb * g.ldb + C) * 2u; }
    const size_t kstep = (size_t)(BK * 2);
    const size_t hstepA = (size_t)HALF * g.lda * 2, hstepB = (size_t)HALF * g.ldb * 2;
    const unsigned ldsw = (unsigned)wid * 1024u;
    const int aoff = lds_byte(wr * 64 + fr, fq * 8), boff = lds_byte(wc * 32 + fr, fq * 8);
#define PG8_SA(b, h) (((b) * 2 + (h)) * HTB)
#define PG8_SB(b, h) ((4 + (b) * 2 + (h)) * HTB)
#define PG8_STAGE(bufoff, gbase, voff) do { _Pragma("unroll") for (int _i = 0; _i < 2; ++_i) \
        __builtin_amdgcn_global_load_lds((const unsigned*)((const char*)(gbase) + (voff)[_i]), (PG8_LAS unsigned*)(lds + (bufoff) + ldsw + _i * 8192), 16, 0, 0); } while (0)
#define PG8_LDA(dst, b, h) do { _Pragma("unroll") for (int m = 0; m < 4; ++m) _Pragma("unroll") for (int k = 0; k < 2; ++k) dst[m][k] = *(const PG8_LAS bf16x8*)(lds + PG8_SA(b, h) + aoff + m * 2048 + k * 1024); } while (0)
#define PG8_LDB(dst, b, h) do { _Pragma("unroll") for (int n = 0; n < 2; ++n) _Pragma("unroll") for (int k = 0; k < 2; ++k) dst[n][k] = *(const PG8_LAS bf16x8*)(lds + PG8_SB(b, h) + boff + n * 2048 + k * 1024); } while (0)
#define PG8_MMA(ai, bj, At, Bt) do { __builtin_amdgcn_s_setprio(1); _Pragma("unroll") for (int m = 0; m < 4; ++m) _Pragma("unroll") for (int n = 0; n < 2; ++n) _Pragma("unroll") for (int k = 0; k < 2; ++k) \
        acc[ai][bj][m][n] = __builtin_amdgcn_mfma_f32_16x16x32_bf16(Bt[n][k], At[m][k], acc[ai][bj][m][n], 0, 0, 0); __builtin_amdgcn_s_setprio(0); } while (0)
#define PG8_WAIT_V(n) asm volatile("s_waitcnt vmcnt(" #n ")" ::: "memory")
#define PG8_WAIT_L(n) asm volatile("s_waitcnt lgkmcnt(" #n ")" ::: "memory")
#define PG8_BAR __builtin_amdgcn_s_barrier()
#define PG8_SCHED __builtin_amdgcn_sched_barrier(0)
    Unit cur, nxt; int ui = 0;
    if (!S.next(0, cur)) return;
    f32x4 acc[2][2][4][2];
#pragma unroll
    for (int a = 0; a < 2; ++a)
#pragma unroll
        for (int b = 0; b < 2; ++b)
#pragma unroll
            for (int m = 0; m < 4; ++m)
#pragma unroll
                for (int n = 0; n < 2; ++n) acc[a][b][m][n] = (f32x4){0.f, 0.f, 0.f, 0.f};
    bf16x8 At[4][2], B0[2][2], B1[2][2];
    const char* cA = (const char*)cur.A; const char* cB = (const char*)cur.B;
    PG8_STAGE(PG8_SB(0, 0), cB, voffB); PG8_STAGE(PG8_SB(0, 1), cB + hstepB, voffB); PG8_STAGE(PG8_SA(0, 0), cA, voffA); PG8_STAGE(PG8_SA(0, 1), cA + hstepA, voffA);
    if (wr == 1) PG8_BAR;
    PG8_WAIT_V(2); PG8_BAR;
    PG8_STAGE(PG8_SB(1, 0), cB + kstep, voffB); PG8_STAGE(PG8_SA(1, 0), cA + kstep, voffA); PG8_STAGE(PG8_SB(1, 1), cB + hstepB + kstep, voffB);
    PG8_WAIT_V(6); PG8_BAR;
    for (;;) {
        const bool has_next = S.next(ui + 1, nxt);
        const char* nA = has_next ? (const char*)nxt.A : cA; const char* nB = has_next ? (const char*)nxt.B : cB;
        for (int t = 0; t < nt; t += 2) {
            const bool last = (t == nt - 2);
            const char* a1 = cA + (size_t)(t + 1) * kstep;
            const char* a2 = last ? nA : cA + (size_t)(t + 2) * kstep; const char* b2 = last ? nB : cB + (size_t)(t + 2) * kstep;
            const char* a3 = a2 + kstep; const char* b3 = b2 + kstep;
            PG8_LDB(B0, 0, 0); PG8_LDB(B1, 0, 1); PG8_SCHED; PG8_LDA(At, 0, 0); PG8_STAGE(PG8_SA(1, 1), a1 + hstepA, voffA);
            PG8_WAIT_V(8); PG8_WAIT_L(0); PG8_BAR; PG8_MMA(0, 0, At, B0); PG8_MMA(0, 1, At, B1); PG8_BAR; PG8_SCHED;
            PG8_LDA(At, 0, 1); PG8_STAGE(PG8_SB(0, 0), b2, voffB); PG8_STAGE(PG8_SB(0, 1), b2 + hstepB, voffB); PG8_STAGE(PG8_SA(0, 0), a2, voffA);
            PG8_WAIT_V(8); PG8_WAIT_L(0); PG8_BAR; PG8_MMA(1, 0, At, B0); PG8_MMA(1, 1, At, B1); PG8_BAR; PG8_SCHED;
            PG8_LDB(B0, 1, 0); PG8_LDB(B1, 1, 1); PG8_SCHED; PG8_LDA(At, 1, 0); PG8_STAGE(PG8_SA(0, 1), a2 + hstepA, voffA);
            PG8_WAIT_V(8); PG8_WAIT_L(0); PG8_BAR; PG8_MMA(0, 0, At, B0); PG8_MMA(0, 1, At, B1); PG8_BAR; PG8_SCHED;
            PG8_LDA(At, 1, 1); PG8_STAGE(PG8_SB(1, 0), b3, voffB); PG8_STAGE(PG8_SB(1, 1), b3 + hstepB, voffB); PG8_STAGE(PG8_SA(1, 0), a3, voffA);
            PG8_WAIT_V(8); PG8_WAIT_L(0); PG8_BAR; PG8_MMA(1, 0, At, B0); PG8_MMA(1, 1, At, B1); PG8_BAR; PG8_SCHED;
        }
        if (wr == 0) PG8_BAR;
        E(acc, cur, wr, wc, fr, fq);
        if (!has_next) break;
#pragma unroll
        for (int a = 0; a < 2; ++a)
#pragma unroll
            for (int b = 0; b < 2; ++b)
#pragma unroll
                for (int m = 0; m < 4; ++m)
#pragma unroll
                    for (int n = 0; n < 2; ++n) acc[a][b][m][n] = (f32x4){0.f, 0.f, 0.f, 0.f};
        cur = nxt; cA = nA; cB = nB; ++ui;
        if (wr == 1) PG8_BAR;
    }
    PG8_WAIT_V(0);
    PG8_BAR;
#undef PG8_SA
#undef PG8_SB
#undef PG8_STAGE
#undef PG8_LDA
#undef PG8_LDB
#undef PG8_MMA
#undef PG8_WAIT_V
#undef PG8_WAIT_L
#undef PG8_SCHED
}

__device__ __forceinline__ float shx(float v, int lane, int m) { return __builtin_bit_cast(float, __builtin_amdgcn_ds_bpermute((lane ^ m) << 2, __builtin_bit_cast(int, v))); }
__device__ __forceinline__ u32x4 pack8(const f32x4 v0, const f32x4 v1) { u32x4 w; w.x = cvt_pk_bf16(v0[0], v0[1]); w.y = cvt_pk_bf16(v0[2], v0[3]); w.z = cvt_pk_bf16(v1[0], v1[1]); w.w = cvt_pk_bf16(v1[2], v1[3]); return w; }
__device__ __forceinline__ void unpack8(const u32x4 w, f32x4& v0, f32x4& v1) { v0[0] = bf_lo(w.x); v0[1] = bf_hi(w.x); v0[2] = bf_lo(w.y); v0[3] = bf_hi(w.y); v1[0] = bf_lo(w.z); v1[1] = bf_hi(w.z); v1[2] = bf_lo(w.w); v1[3] = bf_hi(w.w); }

struct EpiIn {
    const float* b_merge; const float* b_forget; float* LFt; int tok0;
    __device__ __forceinline__ void operator()(f32x4 (&acc)[2][2][4][2], const Unit& u, int wr, int wc, int fr, int fq) const {
        asm volatile("" : "+v"(fr), "+v"(fq));
        const int lane_ = fq * 16 + fr; (void)lane_;
        const int pn = u.pn;
        if (pn < NZT) {
            const int kind = ((pn >= 4 && pn < 8) || (pn >= 20 && pn < 24) || (pn >= 28 && pn < 32)) ? 1 : (pn >= 8 && pn < 12) ? 2 : (pn >= 32) ? 3 : 0;
            bf16_t* base = u.O + (size_t)(wr * 64 + fr) * LDZ + wc * 32 + 8 * fq;
            f32x4 bv[2][2];
#pragma unroll
            for (int bj = 0; bj < 2; ++bj)
#pragma unroll
                for (int n = 0; n < 2; ++n) bv[bj][n] = (kind == 3) ? *(const f32x4*)(b_merge + (pn * 256 - ZC_MG) + wc * 32 + 8 * fq + bj * HALF + 4 * n) : (f32x4){0.f, 0.f, 0.f, 0.f};
#pragma unroll
            for (int ai = 0; ai < 2; ++ai)
#pragma unroll
                for (int m = 0; m < 4; ++m) { bf16_t* rowp = base + (size_t)(ai * HALF + m * 16) * LDZ;
#pragma unroll
                    for (int bj = 0; bj < 2; ++bj) { f32x4 v0 = acc[ai][bj][m][0], v1 = acc[ai][bj][m][1];
                        if (kind == 1) {
#pragma unroll
                            for (int e = 0; e < 4; ++e) { v0[e] = v0[e] * sigm(v0[e]); v1[e] = v1[e] * sigm(v1[e]); } }
                        else if (kind == 2) { v0 = v0 * (0.125f * LOG2E); v1 = v1 * (0.125f * LOG2E); }
                        else if (kind == 3) {
#pragma unroll
                            for (int e = 0; e < 4; ++e) { v0[e] = sigm(v0[e] + bv[bj][0][e]); v1[e] = sigm(v1[e] + bv[bj][1][e]); } }
                        *(u32x4*)(rowp + bj * HALF) = pack8(v0, v1); } }
        } else {
            if (wc == 0 && fq < 2) {
#pragma unroll
                for (int ai = 0; ai < 2; ++ai)
#pragma unroll
                    for (int m = 0; m < 4; ++m) { const int tok = tok0 + u.pm * BM + ai * HALF + wr * 64 + m * 16 + fr; const int bg = tok >> 13, t = tok & (T - 1);
#pragma unroll
                        for (int n = 0; n < 2; ++n)
#pragma unroll
                            for (int e = 0; e < 4; ++e) { const int h = 8 * fq + 4 * n + e; const float x = acc[ai][0][m][n][e] + b_forget[h];
                                const float ls = fminf(x, 0.f) - log1pf(__expf(-fabsf(x)));
                                LFt[(size_t)(bg * 16 + h) * T + t] = ls; } }
            }
        }
    }
};
struct EpiStore {
    __device__ __forceinline__ void operator()(f32x4 (&acc)[2][2][4][2], const Unit& u, int wr, int wc, int fr, int fq) const {
        asm volatile("" : "+v"(fr), "+v"(fq));
        const int lane_ = fq * 16 + fr; (void)lane_;
        bf16_t* base = u.O + (size_t)(wr * 64 + fr) * u.ldo + wc * 32 + 8 * fq;
#pragma unroll
        for (int ai = 0; ai < 2; ++ai)
#pragma unroll
            for (int m = 0; m < 4; ++m) { bf16_t* rowp = base + (size_t)(ai * HALF + m * 16) * u.ldo;
#pragma unroll
                for (int bj = 0; bj < 2; ++bj) *(u32x4*)(rowp + bj * HALF) = pack8(acc[ai][bj][m][0], acc[ai][bj][m][1]); }
    }
};
struct EpiSoftmax {
    PG8_LAS float* xs;
    __device__ __forceinline__ void operator()(f32x4 (&acc)[2][2][4][2], const Unit& u, int wr, int wc, int fr, int fq) const {
        asm volatile("" : "+v"(fr), "+v"(fq));
        const int lane_ = fq * 16 + fr; (void)lane_;
        const float sc = 0.0625f * LOG2E;
        float lm[2][4];
#pragma unroll
        for (int ai = 0; ai < 2; ++ai)
#pragma unroll
            for (int m = 0; m < 4; ++m) {
                float mx = -INFINITY;
#pragma unroll
                for (int bj = 0; bj < 2; ++bj)
#pragma unroll
                    for (int n = 0; n < 2; ++n)
#pragma unroll
                        for (int e = 0; e < 4; ++e) mx = fmaxf(mx, acc[ai][bj][m][n][e]);
                mx = fmaxf(mx, shx(mx, lane_, 16)); mx = fmaxf(mx, shx(mx, lane_, 32)); mx *= sc;
                float s = 0.f;
#pragma unroll
                for (int bj = 0; bj < 2; ++bj)
#pragma unroll
                    for (int n = 0; n < 2; ++n)
#pragma unroll
                        for (int e = 0; e < 4; ++e) { const float p = __builtin_amdgcn_exp2f(acc[ai][bj][m][n][e] * sc - mx); acc[ai][bj][m][n][e] = p; s += p; }
                s += shx(s, lane_, 16); s += shx(s, lane_, 32);
                lm[ai][m] = mx;
                if (fq == 0) { const int row = ai * HALF + wr * 64 + m * 16 + fr; xs[(row * 4 + wc) * 2] = mx; xs[(row * 4 + wc) * 2 + 1] = s; }
            }
        asm volatile("s_waitcnt lgkmcnt(0)" ::: "memory"); PG8_BAR; asm volatile("" ::: "memory");
        bf16_t* base = u.O + (size_t)(wr * 64 + fr) * u.ldo + wc * 32 + 8 * fq;
#pragma unroll
        for (int ai = 0; ai < 2; ++ai)
#pragma unroll
            for (int m = 0; m < 4; ++m) { const int row = ai * HALF + wr * 64 + m * 16 + fr;
                const f32x4 a = *(const PG8_LAS f32x4*)(xs + row * 8), b = *(const PG8_LAS f32x4*)(xs + row * 8 + 4);
                const float M = fmaxf(fmaxf(a[0], a[2]), fmaxf(b[0], b[2]));
                const float tot = a[1] * __builtin_amdgcn_exp2f(a[0] - M) + a[3] * __builtin_amdgcn_exp2f(a[2] - M) + b[1] * __builtin_amdgcn_exp2f(b[0] - M) + b[3] * __builtin_amdgcn_exp2f(b[2] - M);
                const float f = __builtin_amdgcn_exp2f(lm[ai][m] - M) * __builtin_amdgcn_rcpf(tot);
                bf16_t* rowp = base + (size_t)(ai * HALF + m * 16) * u.ldo;
#pragma unroll
                for (int bj = 0; bj < 2; ++bj) *(u32x4*)(rowp + bj * HALF) = pack8(acc[ai][bj][m][0] * f, acc[ai][bj][m][1] * f); }
    }
};
struct EpiMul {
    __device__ __forceinline__ void operator()(f32x4 (&acc)[2][2][4][2], const Unit& u, int wr, int wc, int fr, int fq) const {
        asm volatile("" : "+v"(fr), "+v"(fq));
        const int lane_ = fq * 16 + fr; (void)lane_;
        const size_t lo = (size_t)(wr * 64 + fr) * LDZ + wc * 32 + 8 * fq;
#pragma unroll
        for (int ai = 0; ai < 2; ++ai)
#pragma unroll
            for (int m = 0; m < 4; ++m) { const size_t ro = lo + (size_t)(ai * HALF + m * 16) * LDZ;
#pragma unroll
                for (int bj = 0; bj < 2; ++bj) { const u32x4 gw = *(const u32x4*)(u.G + ro + bj * HALF); f32x4 g0, g1; unpack8(gw, g0, g1);
                    *(u32x4*)(u.O + ro + bj * HALF) = pack8(acc[ai][bj][m][0] * g0, acc[ai][bj][m][1] * g1); } }
    }
};
struct EpiMerge {
    __device__ __forceinline__ void operator()(f32x4 (&acc)[2][2][4][2], const Unit& u, int wr, int wc, int fr, int fq) const {
        asm volatile("" : "+v"(fr), "+v"(fq));
        const int lane_ = fq * 16 + fr; (void)lane_;
        const size_t lo = (size_t)(wr * 64 + fr) * LDZ + wc * 32 + 8 * fq;
#pragma unroll
        for (int ai = 0; ai < 2; ++ai)
#pragma unroll
            for (int m = 0; m < 4; ++m) { const size_t ro = lo + (size_t)(ai * HALF + m * 16) * LDZ;
#pragma unroll
                for (int bj = 0; bj < 2; ++bj) { const u32x4 gw = *(const u32x4*)(u.G + ro + bj * HALF); f32x4 g0, g1; unpack8(gw, g0, g1);
                    f32x4 v0 = acc[ai][bj][m][0] * g0, v1 = acc[ai][bj][m][1] * g1;
                    if (u.z > 0) { const u32x4 pw = *(const u32x4*)(u.O + ro + bj * HALF); f32x4 p0, p1; unpack8(pw, p0, p1); v0 = v0 + p0; v1 = v1 + p1; }
                    *(u32x4*)(u.O + ro + bj * HALF) = pack8(v0, v1); } }
    }
};
struct EpiOut {
    float* SSP;
    __device__ __forceinline__ void operator()(f32x4 (&acc)[2][2][4][2], const Unit& u, int wr, int wc, int fr, int fq) const {
        asm volatile("" : "+v"(fr), "+v"(fq));
        const int lane_ = fq * 16 + fr; (void)lane_;
        bf16_t* base = u.O + (size_t)(wr * 64 + fr) * u.ldo + wc * 32 + 8 * fq;
#pragma unroll
        for (int ai = 0; ai < 2; ++ai)
#pragma unroll
            for (int m = 0; m < 4; ++m) { bf16_t* rowp = base + (size_t)(ai * HALF + m * 16) * u.ldo; float s = 0.f;
#pragma unroll
                for (int bj = 0; bj < 2; ++bj) { const f32x4 v0 = acc[ai][bj][m][0], v1 = acc[ai][bj][m][1];
                    s += (v0[0] * v0[0] + v0[1] * v0[1]) + (v0[2] * v0[2] + v0[3] * v0[3]) + (v1[0] * v1[0] + v1[1] * v1[1]) + (v1[2] * v1[2] + v1[3] * v1[3]);
                    *(u32x4*)(rowp + bj * HALF) = pack8(v0, v1); }
                s += shx(s, lane_, 16); s += shx(s, lane_, 32);
                if (fq == 0) SSP[(size_t)(u.z + ai * HALF + wr * 64 + m * 16 + fr) * 16 + u.pn * 4 + wc] = s; }
    }
};
#undef PG8_BAR
}

namespace attn_body {
using bf16=__hip_bfloat16;
using bf16x8=__attribute__((ext_vector_type(8)))short;
using s16x4=__attribute__((ext_vector_type(4)))short;
using f32x16=__attribute__((ext_vector_type(16)))float;
using f32x4=__attribute__((ext_vector_type(4)))float;
using u32x4=__attribute__((ext_vector_type(4)))unsigned;
constexpr int BATCH=CHB,NHEAD=16,SEQ=T,D=64,DM=LDZ;
constexpr int NW=8,QBLK=32,QB=QBLK*NW,KVBLK=64,NQB=SEQ/QB;
__device__ __forceinline__ int crow(int r,int hi){return (r&3)+8*(r>>2)+4*hi;}
#define SBAR() __builtin_amdgcn_sched_barrier(0)
__device__ __forceinline__ void cmask(f32x16&p0,f32x16&p1,int jb,int qrel,int hi){
  const float NEG=-INFINITY; int kb=64*jb+4*hi;
  #pragma unroll
  for(int r=0;r<16;++r){int kv=kb+(r&3)+8*(r>>2); if(kv>qrel)p0[r]=NEG; if(kv+32>qrel)p1[r]=NEG;}
}
constexpr int NSLOT=3, SLOTB=8192;
constexpr int LDS_K=0, LDS_V=NSLOT*SLOTB, LDS_WS=2*NSLOT*SLOTB, LDS_OST=LDS_WS+NW*64*4, LDS_BIAS=LDS_OST+NW*4096, LDS_BYTES=LDS_BIAS+SEQ*4;
__device__ __forceinline__ void glds16(const void*gsrc,unsigned lds_dst){unsigned keep;
  asm volatile("s_mov_b32 %0, m0\n\ts_mov_b32 m0, %2\n\ts_nop 0\n\tglobal_load_lds_dwordx4 %1, off\n\ts_mov_b32 m0, %0":"=&s"(keep):"v"(gsrc),"s"(lds_dst):"memory");}
__device__ __forceinline__ float max3f(float a,float b,float c){float r;asm("v_max3_f32 %0, %1, %2, %3":"=v"(r):"v"(a),"v"(b),"v"(c));return r;}
__device__ __forceinline__ float max2f(float a,float b){float r;asm("v_max_f32_e32 %0, %1, %2":"=v"(r):"v"(a),"v"(b));return r;}
__device__ __forceinline__ float fadd_s(float a,float b){float r;asm("v_add_f32_e32 %0, %1, %2":"=v"(r):"v"(a),"v"(b));return r;}
__device__ __forceinline__ float fsub_s(float a,float b){float r;asm("v_sub_f32_e32 %0, %1, %2":"=v"(r):"v"(a),"v"(b));return r;}
typedef float f32x2_t __attribute__((ext_vector_type(2))); typedef __bf16 bf16x2_t __attribute__((ext_vector_type(2)));
__device__ __forceinline__ unsigned cvtpk_s(float lo,float hi){f32x2_t v={lo,hi};bf16x2_t b=__builtin_convertvector(v,bf16x2_t);return __builtin_bit_cast(unsigned,b);}
#define WAIT_BAR(N) asm volatile("s_waitcnt vmcnt(" #N ") lgkmcnt(0)\n\ts_barrier":::"memory")
typedef __attribute__((address_space(3))) const char* lds_cptr;
typedef short v4i16_t __attribute__((ext_vector_type(4)));
__device__ __forceinline__ void cinit(f32x16&c0,f32x16&c1,lds_cptr bp,int hi,float negmh){
  #pragma unroll
  for(int g=0;g<4;++g){
    const f32x4 b0=*(const __attribute__((address_space(3))) f32x4*)(bp+(8*g+4*hi)*4);
    const f32x4 b1=*(const __attribute__((address_space(3))) f32x4*)(bp+(32+8*g+4*hi)*4);
    #pragma unroll
    for(int e=0;e<4;++e){c0[4*g+e]=b0[e]+negmh;c1[4*g+e]=b1[e]+negmh;}}
}
__device__ __forceinline__ void qkt(f32x16&p0,f32x16&p1,const char*Kslot,const bf16x8*qr,int r32,int hi){
  const char*kb=Kslot+hi*1024+r32*16;
  #pragma unroll
  for(int d0=0;d0<4;++d0){
    const bf16x8 b0=*reinterpret_cast<const bf16x8*>(kb+d0*2048);
    const bf16x8 b1=*reinterpret_cast<const bf16x8*>(kb+d0*2048+512);
    p0=__builtin_amdgcn_mfma_f32_32x32x16_bf16(b0,qr[d0],p0,0,0,0);p1=__builtin_amdgcn_mfma_f32_32x32x16_bf16(b1,qr[d0],p1,0,0,0);}
}
__device__ __forceinline__ void kload8(bf16x8*kf,lds_cptr kp){
  kf[0]=*(const __attribute__((address_space(3))) bf16x8*)(kp);      kf[1]=*(const __attribute__((address_space(3))) bf16x8*)(kp+512);
  kf[2]=*(const __attribute__((address_space(3))) bf16x8*)(kp+2048); kf[3]=*(const __attribute__((address_space(3))) bf16x8*)(kp+2560);
  kf[4]=*(const __attribute__((address_space(3))) bf16x8*)(kp+4096); kf[5]=*(const __attribute__((address_space(3))) bf16x8*)(kp+4608);
  kf[6]=*(const __attribute__((address_space(3))) bf16x8*)(kp+6144); kf[7]=*(const __attribute__((address_space(3))) bf16x8*)(kp+6656);
}
__device__ __forceinline__ void kload2(bf16x8*kf,lds_cptr kp,int j){ kf[2*j]=*(const __attribute__((address_space(3))) bf16x8*)(kp+j*2048); kf[2*j+1]=*(const __attribute__((address_space(3))) bf16x8*)(kp+j*2048+512); }
__device__ __forceinline__ s16x4 vtr(lds_cptr p){ return __builtin_bit_cast(s16x4,__builtin_amdgcn_ds_read_tr16_b64_v4i16((__attribute__((address_space(3))) v4i16_t*)p)); }
__device__ __forceinline__ float rowmax(const f32x16&p0,const f32x16&p1){
  float a=max3f(p0[0],p0[1],p1[0]),b=max3f(p0[2],p0[3],p1[1]);a=max3f(a,p1[2],p1[3]);
  #pragma unroll
  for(int r=4;r<16;r+=4){a=max3f(a,p0[r],p0[r+1]);b=max3f(b,p0[r+2],p0[r+3]);a=max3f(a,p1[r],p1[r+1]);b=max3f(b,p1[r+2],p1[r+3]);}
  const float m=max2f(a,b);
  auto rr=__builtin_amdgcn_permlane32_swap(__float_as_uint(m),__float_as_uint(m),false,false);
  return max2f(__uint_as_float(rr[0]),__uint_as_float(rr[1]));
}
__device__ __forceinline__ void pv(f32x16*o,int vb,bf16x8 pa0,bf16x8 pa1,bf16x8 pa2,bf16x8 pa3){
  #pragma unroll
  for(int d0=0;d0<2;++d0){s16x4 lo[4],hi[4];
    #pragma unroll
    for(int ks=0;ks<4;++ks){
      asm volatile("ds_read_b64_tr_b16 %0,%1 offset:%c2":"=&v"(lo[ks]):"v"(vb),"i"(d0*4096+ks*1024):"memory");
      asm volatile("ds_read_b64_tr_b16 %0,%1 offset:%c2":"=&v"(hi[ks]):"v"(vb),"i"(d0*4096+ks*1024+512):"memory");}
    asm volatile("s_waitcnt lgkmcnt(0)":::"memory");SBAR();
    #define PK(k) (bf16x8){lo[k][0],lo[k][1],lo[k][2],lo[k][3],hi[k][0],hi[k][1],hi[k][2],hi[k][3]}
    o[d0]=__builtin_amdgcn_mfma_f32_32x32x16_bf16(pa0,PK(0),o[d0],0,0,0);
    o[d0]=__builtin_amdgcn_mfma_f32_32x32x16_bf16(pa1,PK(1),o[d0],0,0,0);
    o[d0]=__builtin_amdgcn_mfma_f32_32x32x16_bf16(pa2,PK(2),o[d0],0,0,0);
    o[d0]=__builtin_amdgcn_mfma_f32_32x32x16_bf16(pa3,PK(3),o[d0],0,0,0);
    #undef PK
  }
}
__device__ __forceinline__ u32x4 mul_bf16x8(u32x4 a,u32x4 b){
  u32x4 r;
  r.x=cvtpk_s(pg8::bf_lo(a.x)*pg8::bf_lo(b.x),pg8::bf_hi(a.x)*pg8::bf_hi(b.x)); r.y=cvtpk_s(pg8::bf_lo(a.y)*pg8::bf_lo(b.y),pg8::bf_hi(a.y)*pg8::bf_hi(b.y));
  r.z=cvtpk_s(pg8::bf_lo(a.z)*pg8::bf_lo(b.z),pg8::bf_hi(a.z)*pg8::bf_hi(b.z)); r.w=cvtpk_s(pg8::bf_lo(a.w)*pg8::bf_lo(b.w),pg8::bf_hi(a.w)*pg8::bf_hi(b.w));
  return r;
}

template<int THRL> __device__ __forceinline__ void attn_unit(int b,int h,int qb,const bf16*Q,const bf16*__restrict__ K,const bf16*__restrict__ V,bf16*O,const bf16*GF,const float*CBh,char*shm){
  int tid_=threadIdx.x; asm volatile("":"+v"(tid_));
  const int tid=tid_,lane=tid&63,r32=lane&31,hi=lane>>5; const int wid=__builtin_amdgcn_readfirstlane(tid>>6);
  const long rowbase=(long)b*SEQ; const int q0=qb*QB;
  const bf16*Qw=Q+(rowbase+q0+wid*QBLK)*DM+h*D;
  const bf16*Kh=K+rowbase*DM+h*D,*Vh=V+rowbase*DM+h*D;
  const unsigned lds0=(unsigned)(uintptr_t)shm;
  float*wsf=(float*)(shm+LDS_WS)+wid*64;
  { const int n4=(q0+QB)>>2; f32x4*dst=(f32x4*)(shm+LDS_BIAS); const f32x4*src=(const f32x4*)CBh;
    for(int i=tid;i<n4;i+=NW*64)dst[i]=src[i];
    asm volatile("s_waitcnt vmcnt(0)":::"memory"); }
  const bf16*ksrc=Kh+(long)lane*DM+wid*8;
  const bf16*vsrc=Vh+(long)(16*(wid&3)+(lane>>2))*DM+(wid>>2)*32+(lane&3)*8;
  const unsigned kdst=lds0+LDS_K+wid*1024, vdst=lds0+LDS_V+wid*1024;
  #define DMA_K(t,slot) glds16(ksrc+(long)(t)*KVBLK*DM,(unsigned)__builtin_amdgcn_readfirstlane(kdst+(slot)))
  #define DMA_V(t,slot) glds16(vsrc+(long)(t)*KVBLK*DM,(unsigned)__builtin_amdgcn_readfirstlane(vdst+(slot)))
  const int vb0=(int)(lds0+LDS_V)+((lane>>4)&1)*32+(lane&3)*8+(4*hi+((lane&15)>>2))*64;
  const char*Kbase=shm+LDS_K; bf16x8 kf[8];
  const lds_cptr shm3=(lds_cptr)shm; const lds_cptr kp0=shm3+LDS_K+hi*1024+r32*16; const lds_cptr vp0=shm3+LDS_V+((lane>>4)&1)*32+(lane&3)*8+(4*hi+((lane&15)>>2))*64;
  const lds_cptr bias0=shm3+LDS_BIAS;
  const int NT=(q0+QB)/KVBLK;
  DMA_K(0,0);DMA_V(0,0);DMA_K(1,SLOTB);
  bf16x8 qr[4];
  #pragma unroll
  for(int d0=0;d0<4;++d0)qr[d0]=*reinterpret_cast<const bf16x8*>(&Qw[(long)r32*DM+d0*16+hi*8]);
  float mhat=0.f,l_reg=0.f;f32x16 o[2];o[0]=f32x16{};o[1]=f32x16{};
  const int qrel=wid*QBLK+r32;
  #define CMASK(P0,P1,t) do{int jb_=(t)-(NT-4); if(jb_>=0)cmask(P0,P1,jb_,qrel,hi);}while(0)
  bool resc=false;
  #define START(P0,P1) do{ const float rm=rowmax(P0,P1); resc=false; \
    { const float dl=rm; mhat=fadd_s(mhat,dl); \
      _Pragma("unroll") for(int r=0;r<16;++r){P0[r]=fsub_s(P0[r],dl);P1[r]=fsub_s(P1[r],dl);} } \
    _Pragma("unroll") for(int r=0;r<16;++r)P0[r]=__builtin_amdgcn_exp2f(P0[r]); }while(0)
  #define RESC() do{ if(resc){ asm volatile("s_waitcnt lgkmcnt(0)":::"memory"); \
      _Pragma("unroll") for(int d_=0;d_<2;++d_) _Pragma("unroll") for(int r=0;r<16;++r)o[d_][r]*=wsf[crow(r,hi)]; } }while(0)
  f32x16 pA0,pA1,pB0,pB1;
  int sl_prev=0,sl_cur=0,sl_next=SLOTB;
  #define ROT() do{sl_prev=sl_cur;sl_cur=sl_next;sl_next=(sl_next==(NSLOT-1)*SLOTB)?0:sl_next+SLOTB;}while(0)
  DMA_K(2,2*SLOTB);
  WAIT_BAR(3);
  cinit(pA0,pA1,bias0,hi,0.f);
  qkt(pA0,pA1,Kbase,qr,r32,hi);asm volatile("s_nop 15\n\ts_nop 7":"+v"(pA0),"+v"(pA1));CMASK(pA0,pA1,0);
  START(pA0,pA1);
  _Pragma("unroll") for(int r=0;r<16;++r)pA1[r]=__builtin_amdgcn_exp2f(pA1[r]);
  WAIT_BAR(0);
  DMA_K(3,0);DMA_V(1,SLOTB);
  ROT();
  kload8(kf,kp0+sl_cur);
  WAIT_BAR(2);
  s16x4 vlo[8],vhi[8]; u32x4 pw0,pw1,pw2,pw3;
  #define PKW(P,B) cvtpk_s(P[B],P[B+1])
  #define PAF(k) __builtin_bit_cast(bf16x8,pw##k)
  #define VFR(i) (bf16x8){vlo[i][0],vlo[i][1],vlo[i][2],vlo[i][3],vhi[i][0],vhi[i][1],vhi[i][2],vhi[i][3]}
  #define PIN(x) asm volatile("":"+v"(x))
  #define MX3(a,b,c) __builtin_fmaxf(__builtin_fmaxf((a),(b)),(c))
  #define GAPA(MF,A0,A1,A2,A3,W0,W1,PW) do{ MF; sacc+=A0; sacc+=A1; sacc+=A2; sacc+=A3; PIN(sacc); W0; W1; PIN(PW); SBAR(); }while(0)
  #define EX(v) __builtin_amdgcn_exp2f(v)
  #define GAPB(MF,X,B) do{ MF; X[B]=EX(X[B]); X[B+1]=EX(X[B+1]); X[B+2]=EX(X[B+2]); X[B+3]=EX(X[B+3]); PIN(X); SBAR(); }while(0)
  #define VRD(i) do{ vlo[i]=vtr(vp_+(((i)>>2)*4096+((i)&3)*1024)); vhi[i]=vtr(vp_+(((i)>>2)*4096+((i)&3)*1024+512)); }while(0)
  #define KRD(G,j) do{ if(G){ kload2(kf,kp0+sl_next,j); SBAR(); } }while(0)
  #define STEP(C0,C1,P0,P1,t,GK,GV,GL) do{ SBAR(); \
    const lds_cptr vp_=vp0+sl_prev; \
    cinit(C0,C1,bias0+(t)*256,hi,-mhat); SBAR(); \
    VRD(0); SBAR(); float sacc=(P0[0]+P0[1]); \
    GAPA(C0=__builtin_amdgcn_mfma_f32_32x32x16_bf16(kf[0],qr[0],C0,0,0,0), P0[2],P0[3],P0[4],P0[5],     pw0[0]=PKW(P0,0), pw0[1]=PKW(P0,2), pw0); \
    VRD(4); SBAR(); GAPA(C1=__builtin_amdgcn_mfma_f32_32x32x16_bf16(kf[1],qr[0],C1,0,0,0), P0[6],P0[7],P0[8],P0[9],     pw0[2]=PKW(P0,4), pw0[3]=PKW(P0,6), pw0); \
    VRD(1); SBAR(); GAPA(C0=__builtin_amdgcn_mfma_f32_32x32x16_bf16(kf[2],qr[1],C0,0,0,0),   P0[10],P0[11],P0[12],P0[13], pw1[0]=PKW(P0,8), pw1[1]=PKW(P0,10), pw1); \
    VRD(5); SBAR(); GAPA(C1=__builtin_amdgcn_mfma_f32_32x32x16_bf16(kf[3],qr[1],C1,0,0,0),   P0[14],P0[15],P1[0],P1[1],   pw1[2]=PKW(P0,12),pw1[3]=PKW(P0,14), pw1); \
    VRD(2); SBAR(); GAPA(C0=__builtin_amdgcn_mfma_f32_32x32x16_bf16(kf[4],qr[2],C0,0,0,0),   P1[2],P1[3],P1[4],P1[5],     pw2[0]=PKW(P1,0), pw2[1]=PKW(P1,2), pw2); \
    VRD(6); SBAR(); GAPA(C1=__builtin_amdgcn_mfma_f32_32x32x16_bf16(kf[5],qr[2],C1,0,0,0),   P1[6],P1[7],P1[8],P1[9],     pw2[2]=PKW(P1,4), pw2[3]=PKW(P1,6), pw2); \
    VRD(3); SBAR(); GAPA(C0=__builtin_amdgcn_mfma_f32_32x32x16_bf16(kf[6],qr[3],C0,0,0,0),   P1[10],P1[11],P1[12],P1[13], pw3[0]=PKW(P1,8), pw3[1]=PKW(P1,10), pw3); \
    VRD(7); SBAR(); GAPA(C1=__builtin_amdgcn_mfma_f32_32x32x16_bf16(kf[7],qr[3],C1,0,0,0),   P1[14],P1[15],0.f,0.f,       pw3[2]=PKW(P1,12),pw3[3]=PKW(P1,14), pw3); \
    l_reg+=sacc; \
    if(GK){DMA_K((t)+3,sl_cur);} if(GV){DMA_V((t)+1,sl_next);} \
    CMASK(C0,C1,t); \
    { float a=MX3(C0[0],C0[1],C1[0]),b=MX3(C0[2],C0[3],C1[1]); a=MX3(a,C1[2],C1[3]); \
      _Pragma("unroll") for(int r=4;r<16;r+=4){a=MX3(a,C0[r],C0[r+1]);b=MX3(b,C0[r+2],C0[r+3]);a=MX3(a,C1[r],C1[r+1]);b=MX3(b,C1[r+2],C1[r+3]);} \
      float rm=__builtin_fmaxf(a,b); { auto rr=__builtin_amdgcn_permlane32_swap(__float_as_uint(rm),__float_as_uint(rm),false,false); rm=__builtin_fmaxf(__uint_as_float(rr[0]),__uint_as_float(rr[1])); } \
      resc=false; \
      if(__builtin_expect(__any(rm>(float)THRL),0)){ const float dl=__builtin_fmaxf(rm,0.f); mhat+=dl; \
        _Pragma("unroll") for(int r=0;r<16;++r){C0[r]-=dl;C1[r]-=dl;} \
        const float f=__builtin_amdgcn_exp2f(-dl); l_reg*=f; if(hi==0)wsf[r32]=f; resc=true; } } \
    SBAR(); \
    GAPB(o[0]=__builtin_amdgcn_mfma_f32_32x32x16_bf16(PAF(0),VFR(0),o[0],0,0,0), C0,0); \
    GAPB(o[1]=__builtin_amdgcn_mfma_f32_32x32x16_bf16(PAF(0),VFR(4),o[1],0,0,0), C0,4); \
    KRD(GL,0); GAPB(o[0]=__builtin_amdgcn_mfma_f32_32x32x16_bf16(PAF(1),VFR(1),o[0],0,0,0), C0,8); \
    KRD(GL,1); GAPB(o[1]=__builtin_amdgcn_mfma_f32_32x32x16_bf16(PAF(1),VFR(5),o[1],0,0,0), C0,12); \
    KRD(GL,2); GAPB(o[0]=__builtin_amdgcn_mfma_f32_32x32x16_bf16(PAF(2),VFR(2),o[0],0,0,0), C1,0); \
    KRD(GL,3); GAPB(o[1]=__builtin_amdgcn_mfma_f32_32x32x16_bf16(PAF(2),VFR(6),o[1],0,0,0), C1,4); \
    GAPB(o[0]=__builtin_amdgcn_mfma_f32_32x32x16_bf16(PAF(3),VFR(3),o[0],0,0,0), C1,8); \
    GAPB(o[1]=__builtin_amdgcn_mfma_f32_32x32x16_bf16(PAF(3),VFR(7),o[1],0,0,0), C1,12); \
    }while(0)
  int t=1;
  #undef CMASK
  #define CMASK(P0,P1,t) do{}while(0)
  for(;t+5<NT;t+=2){
    STEP(pB0,pB1,pA0,pA1,t,true,true,true);     WAIT_BAR(2); RESC(); ROT();
    STEP(pA0,pA1,pB0,pB1,t+1,true,true,true);   WAIT_BAR(2); RESC(); ROT();
  }
  #undef CMASK
  #define CMASK(P0,P1,t) do{int jb_=(t)-(NT-4); if(jb_>=0)cmask(P0,P1,jb_,qrel,hi);}while(0)
  #define ENDW(tt) do{ if((tt)+3<NT){WAIT_BAR(2);} else if((tt)+2<NT){WAIT_BAR(1);} else {WAIT_BAR(0);} }while(0)
  for(;t+1<NT;t+=2){
    STEP(pB0,pB1,pA0,pA1,t,(t+3<NT),(t+1<NT),(t+1<NT));       ENDW(t);   RESC(); ROT();
    STEP(pA0,pA1,pB0,pB1,t+1,(t+4<NT),(t+2<NT),(t+2<NT));     ENDW(t+1); RESC(); ROT();
  }
  STEP(pB0,pB1,pA0,pA1,NT-1,false,false,false); RESC();
  { float sacc=pB0[0]+pB0[1]; _Pragma("unroll") for(int r=2;r<16;++r)sacc+=pB0[r]; _Pragma("unroll") for(int r=0;r<16;++r)sacc+=pB1[r]; l_reg+=sacc;
    pw0=(u32x4){PKW(pB0,0),PKW(pB0,2),PKW(pB0,4),PKW(pB0,6)};pw1=(u32x4){PKW(pB0,8),PKW(pB0,10),PKW(pB0,12),PKW(pB0,14)};pw2=(u32x4){PKW(pB1,0),PKW(pB1,2),PKW(pB1,4),PKW(pB1,6)};pw3=(u32x4){PKW(pB1,8),PKW(pB1,10),PKW(pB1,12),PKW(pB1,14)};
    SBAR(); pv(o,vb0+sl_cur,PAF(0),PAF(1),PAF(2),PAF(3)); }
  #undef PKW
  #undef PAF
  #undef VFR
  #undef PIN
  #undef MX3
  #undef GAPA
  #undef GAPB
  #undef EX
  #undef VRD
  #undef KRD
  #undef STEP
  #undef ENDW
  {auto rr=__builtin_amdgcn_permlane32_swap(__float_as_uint(l_reg),__float_as_uint(l_reg),false,false);l_reg=__uint_as_float(rr[0])+__uint_as_float(rr[1]);}
  if(hi==0)wsf[32+r32]=l_reg;asm volatile("s_waitcnt lgkmcnt(0)":::"memory");
  float rli[16];
  #pragma unroll
  for(int r=0;r<16;++r)rli[r]=__builtin_amdgcn_rcpf(wsf[32+crow(r,hi)]);
  bf16*Ow=O+(rowbase+q0+wid*QBLK)*DM+h*D;
  const bf16*Gw=GF+(rowbase+q0+wid*QBLK)*DM+h*D;
  { bf16*stg=(bf16*)(shm+LDS_OST)+wid*2048;
    #pragma unroll
    for(int r=0;r<16;++r){const int orow=crow(r,hi);
      #pragma unroll
      for(int d0=0;d0<2;++d0)stg[orow*64+d0*32+r32]=__float2bfloat16(o[d0][r]*rli[r]);}
    asm volatile("s_waitcnt lgkmcnt(0)":::"memory");
    #pragma unroll
    for(int i=0;i<4;++i){const int row=i*8+(lane>>3),ch=lane&7; const u32x4 v=*(const u32x4*)(stg+row*64+ch*8); const u32x4 gg=*(const u32x4*)(Gw+(long)row*DM+ch*8);
      *(u32x4*)(Ow+(long)row*DM+ch*8)=mul_bf16x8(v,gg);} }
  asm volatile("s_waitcnt vmcnt(0) lgkmcnt(0)\n\ts_barrier":::"memory");
  #undef DMA_K
  #undef DMA_V
  #undef CMASK
  #undef START
  #undef RESC
  #undef ROT
}
constexpr int ATTN_LDS_BYTES=LDS_BYTES;
#undef SBAR
#undef WAIT_BAR
}

constexpr int NWAVES = 8;
constexpr size_t MiB = 1u << 20;
constexpr size_t WS_CTL = 0, CTL_ZERO_BYTES = 1 * MiB;
constexpr size_t WS_WIN = 2 * MiB, WS_WK = 25 * MiB, WS_WV = 27 * MiB, WS_WB = 29 * MiB, WS_WO = 35 * MiB, WS_WRF = 37 * MiB, WS_COEF = 37 * MiB + 512 * 1024;
constexpr size_t WS_MN = 38 * MiB, WS_MK = 42 * MiB, WS_MVT = 46 * MiB, WS_CB = 50 * MiB, WS_AGG = 54 * MiB, WS_SSP = 56 * MiB;
constexpr size_t WS_XN = 60 * MiB, WS_OUTB = 188 * MiB, WS_Z = 316 * MiB, WS_END = 668 * MiB;
static_assert(WS_WIN + (size_t)NIN * D * 2 <= WS_WK && WS_SSP + (size_t)MTOK * 16 * 4 <= WS_XN && WS_XN + (size_t)MTOK * D * 2 <= WS_OUTB && WS_OUTB + (size_t)MTOK * D * 2 <= WS_Z && WS_Z + (size_t)MC * LDZ * 2 <= WS_END, "d_ws map");
constexpr int CW_BAR = 4096;

constexpr int RING_OFF = 0, RING_BYTES = 131072;
constexpr int LDSCTL_OFF = RING_BYTES, MISC_OFF = LDSCTL_OFF + 320, XS_OFF = LDSCTL_OFF + 1024;
constexpr int LDS_BYTES = 147456;
static_assert(XS_OFF + 8192 <= LDS_BYTES && attn_body::ATTN_LDS_BYTES <= RING_BYTES, "LDS map");

#define GAS __attribute__((address_space(1)))
#define LAS __attribute__((address_space(3)))
typedef unsigned short bf16;
typedef unsigned v4u __attribute__((ext_vector_type(4)));
typedef unsigned v2u __attribute__((ext_vector_type(2)));
typedef float f32x4 __attribute__((ext_vector_type(4)));
typedef float f32x16 __attribute__((ext_vector_type(16)));
typedef short bf16x8 __attribute__((ext_vector_type(8)));
typedef GAS unsigned gu32;
#define LDS_WAIT() asm volatile("s_waitcnt lgkmcnt(0)" ::: "memory")
#define VM_WAIT() asm volatile("s_waitcnt vmcnt(0)" ::: "memory")
__device__ __forceinline__ unsigned f2bf(float f) { unsigned u = __builtin_bit_cast(unsigned, f); return (u + 0x7fffu + ((u >> 16) & 1u)) >> 16; }
__device__ __forceinline__ unsigned pk2(float lo, float hi) { return f2bf(lo) | (f2bf(hi) << 16); }

#define XB_TMO      128
#define XB_XCNT(j)  (256  + 64 * (j))
#define XB_XSUB(j)  (1280 + 64 * (j))
#define XB_XGEN(j)  (2304 + 64 * (j))
#define XB_TOP      3328
#define XB_TOPGEN   3392
#define XCD_BAR_WORDS 3456
#define XB_SPIN_CAP (1u << 22)
__device__ __forceinline__ unsigned xb_ld(unsigned* p)              { return __hip_atomic_load(p, __ATOMIC_RELAXED, __HIP_MEMORY_SCOPE_AGENT); }
__device__ __forceinline__ unsigned xb_add(unsigned* p, unsigned v) { return __hip_atomic_fetch_add(p, v, __ATOMIC_RELAXED, __HIP_MEMORY_SCOPE_AGENT); }
__device__ __forceinline__ unsigned xb_xcc_id() { return (unsigned)__builtin_amdgcn_s_getreg((3 << 11) | 20) & 0xFu; }
#define XB_SPIN(cond, bar) do { unsigned _sp = 0; while (cond) { __builtin_amdgcn_s_sleep(1); \
    if ((++_sp & 255u) == 0u) { if (xb_ld(&(bar)[XB_TMO])) break; if (_sp > XB_SPIN_CAP) { atomicAdd(&(bar)[XB_TMO], 1u); break; } } } } while (0)
struct XcdBarrier { unsigned* bar; unsigned x; volatile LAS unsigned* st; };
__device__ __forceinline__ XcdBarrier xcd_barrier_post(unsigned* bar, volatile LAS unsigned* st) {
    XcdBarrier b; b.bar = bar; b.x = xb_xcc_id(); b.st = st;
    if (threadIdx.x == 0) (void)xb_add(&bar[XB_XCNT(b.x)], 1u);
    return b;
}
__device__ __forceinline__ void xcd_barrier_complete(unsigned* bar, unsigned x, unsigned& nloc, unsigned& nx) {
    const unsigned G = gridDim.x * gridDim.y * gridDim.z;
    unsigned sum, cnt, mine, sp = 0u;
    for (;;) {
        sum = 0u; cnt = 0u; mine = 0u;
#pragma unroll
        for (unsigned j = 0; j < 16; ++j) { const unsigned c = xb_ld(&bar[XB_XCNT(j)]); sum += c; cnt += (c > 0u) ? 1u : 0u; mine = (j == x) ? c : mine; }
        if (sum == G) break;
        __builtin_amdgcn_s_sleep(1);
        if ((++sp & 255u) == 0u) { if (xb_ld(&bar[XB_TMO])) break; if (sp > XB_SPIN_CAP) { atomicAdd(&bar[XB_TMO], 1u); break; } }
    }
    nloc = mine > 0u ? mine : 1u; nx = cnt > 0u ? cnt : 1u;
}
__device__ __forceinline__ void xcd_barrier(const XcdBarrier& b) {
    asm volatile("s_waitcnt vmcnt(0)" ::: "memory");
    __syncthreads();
    if (threadIdx.x == 0) {
        unsigned* bar = b.bar;
        __builtin_amdgcn_s_waitcnt(0);
        unsigned nloc = b.st[0], nx = b.st[1];
        if (nloc == 0u) { xcd_barrier_complete(bar, b.x, nloc, nx); b.st[0] = nloc; b.st[1] = nx; }
        const unsigned old = xb_add(&bar[XB_XSUB(b.x)], 1u);
        const unsigned gen = old / nloc;
        if (old + 1u == (gen + 1u) * nloc) {
            __builtin_amdgcn_fence(__ATOMIC_RELEASE, "agent");
            asm volatile("s_waitcnt vmcnt(0)" ::: "memory");
            const unsigned og = xb_add(&bar[XB_TOP], 1u);
            const unsigned tg = og / nx;
            if (og + 1u == (tg + 1u) * nx) xb_add(&bar[XB_TOPGEN], 1u);
            else XB_SPIN(xb_ld(&bar[XB_TOPGEN]) == tg, bar);
            __builtin_amdgcn_fence(__ATOMIC_ACQUIRE, "agent");
            xb_add(&bar[XB_XGEN(b.x)], 1u);
            asm volatile("s_waitcnt vmcnt(0)" ::: "memory");
        } else {
            XB_SPIN(xb_ld(&bar[XB_XGEN(b.x)]) == gen, bar);
            __builtin_amdgcn_fence(__ATOMIC_ACQUIRE, "agent");
            asm volatile("s_waitcnt vmcnt(0)" ::: "memory");
        }
    }
    __syncthreads();
}

template <class T_> __device__ __forceinline__ T_* as_global(T_* p) { return (T_*)(GAS T_*)p; }
struct Args {
    const float *x, *mem, *g_pre, *w_in, *conv_w, *conv_b, *w_lru_r, *b_lru_r, *w_lru_i, *b_lru_i, *lru_lambda, *b_forget, *g_mem, *w_mem_k, *w_mem_v, *w_branch, *b_merge, *w_out, *g_post;
    float* out; unsigned char* ws;
};

__device__ __forceinline__ float wave_sum(float v) {
#pragma unroll
    for (int o = 1; o < 64; o <<= 1) v += __shfl_xor(v, o);
    return v;
}
__device__ __forceinline__ void p0_transpose_item(const float* W, int ld, int K, int ncols, bf16* WT, LAS float* scr, int item, int lane) {
    const int nblk = ncols / 32, kb = item / nblk, nb = item % nblk, k0 = 64 * kb, n0 = 32 * nb;
#pragma unroll 8
    for (int i = 0; i < 32; ++i) { const int kk = 2 * i + (lane >> 5); scr[kk * 33 + (lane & 31)] = W[(size_t)(k0 + kk) * ld + n0 + (lane & 31)]; }
    LDS_WAIT(); asm volatile("" ::: "memory");
    const int c = lane & 7;
#pragma unroll
    for (int j = 0; j < 4; ++j) { const int n = (lane >> 3) + 8 * j; const LAS float* s = scr + (8 * c) * 33 + n;
        v4u o; o.x = pk2(s[0 * 33], s[1 * 33]); o.y = pk2(s[2 * 33], s[3 * 33]); o.z = pk2(s[4 * 33], s[5 * 33]); o.w = pk2(s[6 * 33], s[7 * 33]);
        *(GAS v4u*)(WT + (size_t)(n0 + n) * K + k0 + 8 * c) = o; }
    LDS_WAIT(); asm volatile("" ::: "memory");
}
__device__ __forceinline__ void rms_row_to_bf16(const float* xrow, const float* g, bf16* orow, int lane) {
    const GAS f32x4* xr = (const GAS f32x4*)xrow + lane; const GAS f32x4* gr = (const GAS f32x4*)g + lane;
    f32x4 v[4]; float s = 0.f;
#pragma unroll
    for (int j = 0; j < 4; ++j) { v[j] = xr[64 * j]; s += (v[j].x * v[j].x + v[j].y * v[j].y) + (v[j].z * v[j].z + v[j].w * v[j].w); }
    const float rs = 1.f / sqrtf(wave_sum(s) * (1.f / D) + RMS_EPS);
    GAS unsigned long long* o8 = (GAS unsigned long long*)orow + lane;
#pragma unroll
    for (int j = 0; j < 4; ++j) { const f32x4 gg = gr[64 * j];
        o8[64 * j] = (unsigned long long)pk2(v[j].x * rs * gg.x, v[j].y * rs * gg.y) | ((unsigned long long)pk2(v[j].z * rs * gg.z, v[j].w * rs * gg.w) << 32); }
}

struct LruPtrs { const float *conv_w, *conv_b, *b_lru_r, *b_lru_i; unsigned char* ws; };
template <int PASS>
__device__ __forceinline__ void lru_unit(const LruPtrs& args, LAS unsigned char* lds, int chunk, int bl, int g, int ck) {
    int tid_ = threadIdx.x; asm volatile("" : "+v"(tid_));
    const int tid = tid_, lane = tid & 63, n = lane & 31, hi = lane >> 5; const int w = __builtin_amdgcn_readfirstlane(tid >> 6);
    unsigned char* ws = args.ws; asm volatile("" : "+s"(ws)); ws = as_global(ws);
    bf16* Z = (bf16*)(ws + WS_Z);
    float* AGG = (float*)(ws + WS_AGG);
    LAS float* WAG = (LAS float*)(lds + RING_OFF);
    LAS float* CARW = (LAS float*)(lds + RING_OFF + 8192);
    LAS float* PRM = (LAS float*)(lds + RING_OFF + 12288);
    { const float* src = (w < 4) ? args.conv_w + w * D : (w == 4) ? args.conv_b : (w == 5) ? args.b_lru_r : (w == 6) ? args.b_lru_i : (const float*)(ws + WS_COEF);
      PRM[w * 64 + lane] = src[g * 64 + lane]; }
    const int tl = ck * 256 + w * 32 + n;
    const size_t zr = (size_t)bl * T + tl;
    const int cb0 = g * 64 + 4 * hi;
    v2u xw[4][8];
#pragma unroll
    for (int k = 0; k < 4; ++k) {
        const int ts = tl - 3 + k; const bool ok = ts >= 0;
        const bf16* rp = Z + (zr - 3 + k) * LDZ + ZC_AX + cb0;
#pragma unroll
        for (int q = 0; q < 8; ++q) { xw[k][q] = (v2u){0u, 0u}; if (ok) xw[k][q] = *(const v2u*)(rp + 8 * q); }
    }
    __syncthreads();
    float xc[8][4];
#pragma unroll
    for (int q = 0; q < 8; ++q) { const f32x4 bb = *(const LAS f32x4*)(PRM + 4 * 64 + 8 * q + 4 * hi);
#pragma unroll
        for (int p = 0; p < 4; ++p) xc[q][p] = bb[p]; }
#pragma unroll
    for (int k = 0; k < 4; ++k) {
#pragma unroll
        for (int q = 0; q < 8; ++q) { const f32x4 cw = *(const LAS f32x4*)(PRM + k * 64 + 8 * q + 4 * hi);
            xc[q][0] += cw[0] * pg8::bf_lo(xw[k][q].x); xc[q][1] += cw[1] * pg8::bf_hi(xw[k][q].x); xc[q][2] += cw[2] * pg8::bf_lo(xw[k][q].y); xc[q][3] += cw[3] * pg8::bf_hi(xw[k][q].y); }
    }
    f32x16 ar[2], ai_[2];
#pragma unroll
    for (int rb = 0; rb < 2; ++rb) { ar[rb] = f32x16{}; ai_[rb] = f32x16{}; }
    const bf16* wrf = (const bf16*)(ws + WS_WRF) + (size_t)g * (2 * 2 * 4 * 64 * 8) + lane * 8;
#pragma unroll
    for (int ks = 0; ks < 4; ++ks) {
        v4u bw; bw.x = pg8::cvt_pk_bf16(xc[2 * ks][0], xc[2 * ks][1]); bw.y = pg8::cvt_pk_bf16(xc[2 * ks][2], xc[2 * ks][3]); bw.z = pg8::cvt_pk_bf16(xc[2 * ks + 1][0], xc[2 * ks + 1][1]); bw.w = pg8::cvt_pk_bf16(xc[2 * ks + 1][2], xc[2 * ks + 1][3]);
        const bf16x8 bfr = __builtin_bit_cast(bf16x8, bw);
#pragma unroll
        for (int rb = 0; rb < 2; ++rb) {
            const bf16x8 wr_ = __builtin_bit_cast(bf16x8, *(const v4u*)(wrf + ((0 * 2 + rb) * 4 + ks) * 512));
            const bf16x8 wi_ = __builtin_bit_cast(bf16x8, *(const v4u*)(wrf + ((1 * 2 + rb) * 4 + ks) * 512));
            ar[rb] = __builtin_amdgcn_mfma_f32_32x32x16_bf16(wr_, bfr, ar[rb], 0, 0, 0);
            ai_[rb] = __builtin_amdgcn_mfma_f32_32x32x16_bf16(wi_, bfr, ai_[rb], 0, 0, 0);
        }
    }
    float av[8][4], uv[8][4];
#pragma unroll
    for (int q = 0; q < 8; ++q) {
        const f32x4 br = *(const LAS f32x4*)(PRM + 5 * 64 + 8 * q + 4 * hi), bi = *(const LAS f32x4*)(PRM + 6 * 64 + 8 * q + 4 * hi), cf = *(const LAS f32x4*)(PRM + 7 * 64 + 8 * q + 4 * hi);
#pragma unroll
        for (int p = 0; p < 4; ++p) { const int rb = q >> 2, r = (q & 3) * 4 + p;
            const float rr = pg8::sigm(ar[rb][r] + br[p]), ii = pg8::sigm(ai_[rb][r] + bi[p]);
            const float a = __builtin_amdgcn_exp2f(cf[p] * rr);
            const float m2 = fmaxf(1.f - a * a, 0.f);
            av[q][p] = a; uv[q][p] = sqrtf(m2) * (ii * xc[q][p]); }
    }
#pragma unroll
    for (int d = 1; d < 32; d <<= 1) {
        const bool on = n >= d;
#pragma unroll
        for (int q = 0; q < 8; ++q)
#pragma unroll
            for (int p = 0; p < 4; ++p) { const float ap = __shfl_up(av[q][p], d, 32), up = __shfl_up(uv[q][p], d, 32);
                if (on) { uv[q][p] = av[q][p] * up + uv[q][p]; av[q][p] = av[q][p] * ap; } }
    }
    if (n == 31) {
#pragma unroll
        for (int q = 0; q < 8; ++q)
#pragma unroll
            for (int p = 0; p < 4; ++p) { const int ci = 8 * q + 4 * hi + p; WAG[(w * 64 + ci) * 2] = av[q][p]; WAG[(w * 64 + ci) * 2 + 1] = uv[q][p]; }
    }
    __syncthreads();
    if (PASS == 1) {
        if (w == 0) { float A = 1.f, H = 0.f;
#pragma unroll
            for (int ww = 0; ww < 8; ++ww) { const float a = WAG[(ww * 64 + lane) * 2], h = WAG[(ww * 64 + lane) * 2 + 1]; H = a * H + h; A = A * a; }
            float* dst = AGG + ((size_t)(bl * 32 + ck) * D + g * 64 + lane) * 2; dst[0] = A; dst[1] = H; }
        __syncthreads();
    } else {
        if (w == 0) { float H = 0.f;
            for (int cc = 0; cc < ck; ++cc) { const float* src = AGG + ((size_t)(bl * 32 + cc) * D + g * 64 + lane) * 2; H = src[0] * H + src[1]; }
#pragma unroll
            for (int ww = 0; ww < 8; ++ww) { CARW[ww * 64 + lane] = H; const float a = WAG[(ww * 64 + lane) * 2], h = WAG[(ww * 64 + lane) * 2 + 1]; H = a * H + h; } }
        __syncthreads();
        bf16* gp = Z + zr * LDZ + ZC_GA + cb0;
#pragma unroll
        for (int q = 0; q < 8; ++q) { const f32x4 cr = *(const LAS f32x4*)(CARW + w * 64 + 8 * q + 4 * hi);
            const v2u gw = *(const v2u*)(gp + 8 * q);
            const float h0 = (uv[q][0] + av[q][0] * cr[0]) * pg8::bf_lo(gw.x), h1 = (uv[q][1] + av[q][1] * cr[1]) * pg8::bf_hi(gw.x);
            const float h2 = (uv[q][2] + av[q][2] * cr[2]) * pg8::bf_lo(gw.y), h3 = (uv[q][3] + av[q][3] * cr[3]) * pg8::bf_hi(gw.y);
            v2u o; o.x = pg8::cvt_pk_bf16(h0, h1); o.y = pg8::cvt_pk_bf16(h2, h3); *(v2u*)(gp + 8 * q) = o; }
        __syncthreads();
    }
}

__device__ __forceinline__ void cumsum_unit(float* CBh, LAS unsigned char* lds) {
    int tid_ = threadIdx.x; asm volatile("" : "+v"(tid_));
    const int tid = tid_, lane = tid & 63, w = tid >> 6;
    LAS float* wsum = (LAS float*)(lds + RING_OFF + 16384);
    f32x4 v[4]; float s = 0.f;
#pragma unroll
    for (int j = 0; j < 4; ++j) { v[j] = *(const f32x4*)(CBh + tid * 16 + 4 * j);
#pragma unroll
        for (int e = 0; e < 4; ++e) { s += v[j][e]; v[j][e] = s; } }
    float inc = s;
#pragma unroll
    for (int d = 1; d < 64; d <<= 1) { const float o = __shfl_up(inc, d, 64); if (lane >= d) inc += o; }
    if (lane == 63) wsum[w] = inc;
    __syncthreads();
    float off = inc - s;
    for (int ww = 0; ww < w; ++ww) off += wsum[ww];
#pragma unroll
    for (int j = 0; j < 4; ++j) { f32x4 o;
#pragma unroll
        for (int e = 0; e < 4; ++e) o[e] = -(off + v[j][e]) * LOG2E;
        *(f32x4*)(CBh + tid * 16 + 4 * j) = o; }
    __syncthreads();
}

struct SchedIn { pg8::TileOrder o; const bf16* XNc; const bf16* WinT; bf16* Z;
    __device__ __forceinline__ bool next(int i, pg8::Unit& u) const { int pm, pn; if (!o.map(i, pm, pn)) return false; u.pm = pm; u.pn = pn; u.z = 0; u.ldo = LDZ;
        u.A = XNc + (size_t)pm * 256 * D; u.B = WinT + (size_t)pn * 256 * D; u.O = Z + (size_t)pm * 256 * LDZ + (pn < NZT ? pn : 0) * 256; u.G = nullptr; return true; } };
struct SchedMemKV { int q; const bf16 *MN, *WkT, *WvT; bf16 *MK, *MVT;
    __device__ __forceinline__ bool next(int i, pg8::Unit& u) const { if (i > 0 || q < 0 || q >= 64) return false; u.z = 0; u.G = nullptr;
        if (q < 32) { const int pm = q >> 2, pn = q & 3; u.pm = pm; u.pn = pn; u.A = MN + (size_t)pm * 256 * D; u.B = WkT + (size_t)pn * 256 * D; u.O = MK + (size_t)pm * 256 * D + pn * 256; u.ldo = D; }
        else { const int b = (q - 32) >> 2, pm = (q - 32) & 3; u.pm = pm; u.pn = 0; u.A = WvT + (size_t)pm * 256 * D; u.B = MN + (size_t)b * MEMLEN * D; u.O = MVT + (size_t)b * D * MEMLEN + (size_t)pm * 256 * MEMLEN; u.ldo = MEMLEN; }
        return true; } };
struct SchedMemS { int G, c, chunk; bf16* Z; const bf16* MK;
    __device__ __forceinline__ bool next(int i, pg8::Unit& u) const { const int L = i * G + c; if (L >= 256) return false; const int bl = L >> 7, h = (L >> 5) & 3, pmb = L & 31;
        const size_t r0 = (size_t)bl * T + pmb * 256; u.pm = pmb; u.pn = 0; u.z = 0; u.ldo = LDZ;
        u.A = Z + r0 * LDZ + ZC_MQ + h * 256; u.B = MK + (size_t)((chunk * CHB + bl) * MEMLEN) * D + h * 256; u.O = Z + r0 * LDZ + ZC_MQ + h * 256; u.G = nullptr; return true; } };
struct SchedMemPV { int G, c, chunk; bf16* Z; const bf16* MVT;
    __device__ __forceinline__ bool next(int i, pg8::Unit& u) const { const int L = i * G + c; if (L >= 256) return false; const int bl = L >> 7, h = (L >> 5) & 3, pmb = L & 31;
        const size_t r0 = (size_t)bl * T + pmb * 256; u.pm = pmb; u.pn = 0; u.z = 0; u.ldo = LDZ;
        u.A = Z + r0 * LDZ + ZC_MQ + h * 256; u.B = MVT + (size_t)(chunk * CHB + bl) * D * MEMLEN + (size_t)h * 256 * MEMLEN; u.O = Z + r0 * LDZ + ZC_MQ + h * 256; u.G = Z + r0 * LDZ + ZC_GM + h * 256; return true; } };
struct SchedMerge { pg8::TileOrder o; bf16* Z; const bf16* WBt;
    __device__ __forceinline__ bool next(int i, pg8::Unit& u) const { int pm, pn; if (!o.map(i / 3, pm, pn)) return false; const int nb = i % 3; u.pm = pm; u.pn = pn; u.z = nb; u.ldo = LDZ;
        const int acol = nb == 0 ? ZC_GA : nb == 1 ? ZC_Q : ZC_MQ;
        u.A = Z + (size_t)pm * 256 * LDZ + acol; u.B = WBt + (size_t)nb * D * D + (size_t)pn * 256 * D; u.O = Z + (size_t)pm * 256 * LDZ + ZC_K + pn * 256; u.G = Z + (size_t)pm * 256 * LDZ + ZC_MG + nb * D + pn * 256; return true; } };
struct SchedOut { pg8::TileOrder o; const bf16* Z; const bf16* WoT; bf16* OUTB; int chunk;
    __device__ __forceinline__ bool next(int i, pg8::Unit& u) const { int pm, pn; if (!o.map(i, pm, pn)) return false; u.pm = pm; u.pn = pn; u.z = chunk * MC + pm * 256; u.ldo = D;
        u.A = Z + (size_t)pm * 256 * LDZ + ZC_K; u.B = WoT + (size_t)pn * 256 * D; u.O = OUTB + (size_t)(chunk * MC + pm * 256) * D + pn * 256; u.G = nullptr; return true; } };

__global__ void __launch_bounds__(NWAVES * 64, 2) hybrid_fwd(Args args) {
    extern __shared__ __attribute__((aligned(16))) unsigned char lds_raw[];
    LAS unsigned char* lds = (LAS unsigned char*)lds_raw;
    volatile LAS unsigned* MISC = (volatile LAS unsigned*)(lds + MISC_OFF);
    const int tid = threadIdx.x, lane = tid & 63, wave = __builtin_amdgcn_readfirstlane(tid >> 6);
    const int G = gridDim.x, c = blockIdx.x;
    typedef const __attribute__((address_space(4))) Args* KArgs;
#define KA() ({ KArgs p_ = (KArgs)__builtin_amdgcn_kernarg_segment_ptr(); asm volatile("" : "+s"(p_)); p_; })
    unsigned char* ws = KA()->ws;
    gu32* ctl = (gu32*)(ws + WS_CTL);
    bf16* WinT = (bf16*)(ws + WS_WIN); bf16* WkT = (bf16*)(ws + WS_WK); bf16* WvT = (bf16*)(ws + WS_WV); bf16* WBt = (bf16*)(ws + WS_WB); bf16* WoT = (bf16*)(ws + WS_WO);
    bf16* MN = (bf16*)(ws + WS_MN); bf16* MK = (bf16*)(ws + WS_MK); bf16* MVT = (bf16*)(ws + WS_MVT);
    float* CB = (float*)(ws + WS_CB); float* SSP = (float*)(ws + WS_SSP);
    bf16* XN = (bf16*)(ws + WS_XN); bf16* OUTB = (bf16*)(ws + WS_OUTB); bf16* Z = (bf16*)(ws + WS_Z);
    for (int u = tid; u < (LDS_BYTES - LDSCTL_OFF) / 4; u += NWAVES * 64) ((LAS unsigned*)(lds + LDSCTL_OFF))[u] = 0u;
    __syncthreads();
    (void)xcd_barrier_post((unsigned*)(ctl + CW_BAR), MISC + 8);
#define GRID_BAR() do { XcdBarrier bar_; bar_.bar = (unsigned*)(KA()->ws + WS_CTL) + CW_BAR; bar_.x = xb_xcc_id(); bar_.st = MISC + 8; xcd_barrier(bar_); } while (0)

    {
        KArgs args = KA();
        LAS float* scr = (LAS float*)(lds + RING_OFF + wave * 16384);
        const int gw = c * NWAVES + wave, NGW = G * NWAVES;
        constexpr int I_A = 16 * (5120 / 32), I_B = 16 * (6144 / 32), I_S = 16 * 32;
        constexpr int NITEMS = I_A + I_B + 6 * I_S;
        for (int it = gw; it < NITEMS; it += NGW) {
            int r = it;
            if (r < I_A) { p0_transpose_item(args->w_in, IN_COLS, D, 5120, WinT, scr, r, lane); continue; } r -= I_A;
            if (r < I_B) { p0_transpose_item(args->w_in + 5136, IN_COLS, D, 6144, WinT + (size_t)5120 * D, scr, r, lane); continue; } r -= I_B;
            if (r < I_S) { p0_transpose_item(args->w_mem_k, D, D, D, WkT, scr, r, lane); continue; } r -= I_S;
            if (r < I_S) { p0_transpose_item(args->w_mem_v, D, D, D, WvT, scr, r, lane); continue; } r -= I_S;
            if (r < 3 * I_S) { const int nb = r / I_S; p0_transpose_item(args->w_branch + (size_t)nb * D * D, D, D, D, WBt + (size_t)nb * D * D, scr, r % I_S, lane); continue; } r -= 3 * I_S;
            p0_transpose_item(args->w_out, D, D, D, WoT, scr, r, lane);
        }
        const int gt = c * (NWAVES * 64) + tid, NGT = G * NWAVES * 64;
        for (int e = gt; e < 256 * 128; e += NGT) { const int row = e >> 7, k8 = (e & 127) * 8; v4u o = (v4u){0u, 0u, 0u, 0u};
            if (row < 16) { const float* s = args->w_in + (size_t)k8 * IN_COLS + 5120 + row;
                o.x = pk2(s[0], s[IN_COLS]); o.y = pk2(s[2 * IN_COLS], s[3 * IN_COLS]); o.z = pk2(s[4 * IN_COLS], s[5 * IN_COLS]); o.w = pk2(s[6 * IN_COLS], s[7 * IN_COLS]); }
            *(v4u*)(WinT + (size_t)(LDZ + row) * D + k8) = o; }
        for (int e = gt; e < 16 * 2 * 2 * 4 * 64; e += NGT) { const int ln = e & 63, ks = (e >> 6) & 3, rb = (e >> 8) & 1, mat = (e >> 9) & 1, gg = e >> 10;
            const float* Wm = (mat ? args->w_lru_i : args->w_lru_r) + (size_t)gg * 64 * 64; const int j = 32 * rb + (ln & 31), hh = ln >> 5;
            float f[8];
#pragma unroll
            for (int q = 0; q < 8; ++q) { const int k = 8 * (2 * ks + (q >> 2)) + 4 * hh + (q & 3); f[q] = Wm[k * 64 + j]; }
            v4u o; o.x = pk2(f[0], f[1]); o.y = pk2(f[2], f[3]); o.z = pk2(f[4], f[5]); o.w = pk2(f[6], f[7]);
            *(v4u*)((bf16*)(ws + WS_WRF) + (size_t)e * 8) = o; }
        for (int e = gt; e < D; e += NGT) { const float x = -args->lru_lambda[e]; const float sp = fmaxf(x, 0.f) + log1pf(expf(-fabsf(x))); ((float*)(ws + WS_COEF))[e] = -8.f * sp * LOG2E; }
        for (int m = gw; m < MTOK; m += NGW) rms_row_to_bf16(args->x + (size_t)m * D, args->g_pre, XN + (size_t)m * D, lane);
        for (int m = gw; m < NB * MEMLEN; m += NGW) rms_row_to_bf16(args->mem + (size_t)m * D, args->g_mem, MN + (size_t)m * D, lane);
    }
    cg::this_grid().sync();
    GRID_BAR();

    for (int chunk = 0; chunk < NCHUNK; ++chunk) {
        unsigned char* wsl = as_global(KA()->ws);
        int c = blockIdx.x, G = gridDim.x; asm volatile("" : "+s"(c), "+s"(G));
        bf16* WinT = (bf16*)(wsl + WS_WIN); bf16* WkT = (bf16*)(wsl + WS_WK); bf16* WvT = (bf16*)(wsl + WS_WV); bf16* WBt = (bf16*)(wsl + WS_WB); bf16* WoT = (bf16*)(wsl + WS_WO);
        bf16* MN = (bf16*)(wsl + WS_MN); bf16* MK = (bf16*)(wsl + WS_MK); bf16* MVT = (bf16*)(wsl + WS_MVT);
        float* CB = (float*)(wsl + WS_CB); float* SSP = (float*)(wsl + WS_SSP);
        bf16* XN = (bf16*)(wsl + WS_XN); bf16* OUTB = (bf16*)(wsl + WS_OUTB); bf16* Z = (bf16*)(wsl + WS_Z);
        {
            pg8::Gemm g{D, D, D}; SchedIn S; S.o.init(MC / 256, NIN / 256, G, c); S.XNc = XN + (size_t)chunk * MC * D; S.WinT = WinT; S.Z = Z;
            pg8::EpiIn E{as_global(KA()->b_merge), as_global(KA()->b_forget), CB, chunk * MC};
            pg8::gemm_phase<pg8::EpiIn, SchedIn>(lds + RING_OFF, g, S, E);
            if (chunk == 0) {
                SchedMemKV S2{(c >= 64 && c < 128) ? c - 64 : -1, MN, WkT, WvT, MK, MVT}; pg8::EpiStore E2;
                pg8::gemm_phase<pg8::EpiStore, SchedMemKV>(lds + RING_OFF, g, S2, E2);
            }
        }
        GRID_BAR();
        {
            { KArgs ka = KA(); const LruPtrs lp{as_global(ka->conv_w), as_global(ka->conv_b), as_global(ka->b_lru_r), as_global(ka->b_lru_i), as_global(ka->ws)};
              for (int L = c; L < CHB * 16 * 32; L += G) lru_unit<1>(lp, lds, chunk, L >> 9, (L >> 5) & 15, L & 31); }
            for (int L = c; L < CHB * 16; L += G) cumsum_unit(CB + (size_t)(chunk * CHB * 16 + L) * T, lds);
            pg8::Gemm g{LDZ, D, 256}; SchedMemS S{G, c, chunk, Z, MK}; pg8::EpiSoftmax E{(PG8_LAS float*)(lds + XS_OFF)};
            pg8::gemm_phase<pg8::EpiSoftmax, SchedMemS>(lds + RING_OFF, g, S, E);
        }
        GRID_BAR();
        {
            if (G == 256) {
                const int vcu = (c % 8) * (G / 8) + c / 8, s = vcu & 7, bh = vcu >> 3;
                for (int i = 0; i < 4; ++i) { const int qb = (i == 0) ? s : (i == 1) ? 15 - s : (i == 2) ? 16 + s : 31 - s;
                    attn_body::attn_unit<8>(bh / 16, bh % 16, qb, (const attn_body::bf16*)(Z + ZC_Q), (const attn_body::bf16*)(Z + ZC_K), (const attn_body::bf16*)(Z + ZC_V), (attn_body::bf16*)(Z + ZC_Q),
                                            (const attn_body::bf16*)(Z + ZC_GF), CB + (size_t)(chunk * CHB * 16 + bh) * T, (char*)lds_raw + RING_OFF); }
            } else {
                for (int L = c; L < CHB * 16 * 32; L += G) { const int bh = L >> 5, qb = L & 31;
                    attn_body::attn_unit<8>(bh / 16, bh % 16, qb, (const attn_body::bf16*)(Z + ZC_Q), (const attn_body::bf16*)(Z + ZC_K), (const attn_body::bf16*)(Z + ZC_V), (attn_body::bf16*)(Z + ZC_Q),
                                            (const attn_body::bf16*)(Z + ZC_GF), CB + (size_t)(chunk * CHB * 16 + bh) * T, (char*)lds_raw + RING_OFF); }
            }
            { KArgs ka = KA(); const LruPtrs lp{as_global(ka->conv_w), as_global(ka->conv_b), as_global(ka->b_lru_r), as_global(ka->b_lru_i), as_global(ka->ws)};
              for (int L = c; L < CHB * 16 * 32; L += G) lru_unit<3>(lp, lds, chunk, L >> 9, (L >> 5) & 15, L & 31); }
            pg8::Gemm g{LDZ, MEMLEN, 256}; SchedMemPV S{G, c, chunk, Z, MVT}; pg8::EpiMul E;
            pg8::gemm_phase<pg8::EpiMul, SchedMemPV>(lds + RING_OFF, g, S, E);
        }
        GRID_BAR();
        {
            pg8::Gemm g{LDZ, D, D}; SchedMerge S; S.o.init(MC / 256, D / 256, G, c); S.Z = Z; S.WBt = WBt; pg8::EpiMerge E;
            pg8::gemm_phase<pg8::EpiMerge, SchedMerge>(lds + RING_OFF, g, S, E);
        }
        GRID_BAR();
        {
            pg8::Gemm g{LDZ, D, D}; SchedOut S; S.o.init(MC / 256, D / 256, G, c); S.Z = Z; S.WoT = WoT; S.OUTB = OUTB; S.chunk = chunk; pg8::EpiOut E{SSP};
            pg8::gemm_phase<pg8::EpiOut, SchedOut>(lds + RING_OFF, g, S, E);
        }
        GRID_BAR();
    }
    {
        KArgs args = KA();
        const float* SSP = (const float*)(as_global(args->ws) + WS_SSP); const bf16* OUTB = (const bf16*)(as_global(args->ws) + WS_OUTB);
        const float* xg_ = as_global(args->x); const float* gpost_ = as_global(args->g_post); float* outg_ = as_global(args->out);
        int tid_ = threadIdx.x; asm volatile("" : "+v"(tid_)); const int lane = tid_ & 63, wave = __builtin_amdgcn_readfirstlane(tid_ >> 6);
        const int gw = c * NWAVES + wave, NGW = G * NWAVES;
        for (int m = gw; m < MTOK; m += NGW) {
            float sp = (lane < 16) ? SSP[(size_t)m * 16 + lane] : 0.f; sp = wave_sum(sp);
            const float rs = 1.f / sqrtf(sp * (1.f / D) + RMS_EPS);
            const f32x4* xr = (const f32x4*)(xg_ + (size_t)m * D) + lane; const f32x4* gr = (const f32x4*)gpost_ + lane;
            const v2u* orow = (const v2u*)(OUTB + (size_t)m * D) + lane; f32x4* yr = (f32x4*)(outg_ + (size_t)m * D) + lane;
#pragma unroll
            for (int j = 0; j < 4; ++j) { const f32x4 xv = xr[64 * j], gg = gr[64 * j]; const v2u ow = orow[64 * j]; f32x4 y;
                y.x = xv.x + pg8::bf_lo(ow.x) * rs * gg.x; y.y = xv.y + pg8::bf_hi(ow.x) * rs * gg.y; y.z = xv.z + pg8::bf_lo(ow.y) * rs * gg.z; y.w = xv.w + pg8::bf_hi(ow.y) * rs * gg.w;
                yr[64 * j] = y; }
        }
    }
#undef GRID_BAR
#undef KA
}

extern "C" void kernel_launch(void* const* d_in, const int* in_sizes, int n_in, void* d_out, int out_size, void* d_ws, size_t ws_size, hipStream_t stream) {
    static int grid = 0;
    if (grid == 0) {
        if (n_in != 19 || in_sizes[0] != MTOK * D || out_size != MTOK * D || ws_size < WS_END) { fprintf(stderr, "kernel_launch: unexpected shapes (n_in %d, in0 %d, out %d, ws %zu); nothing launched\n", n_in, n_in > 0 ? in_sizes[0] : -1, out_size, ws_size); grid = -1; return; }
        int dev = 0, cus = 0, per_cu = 0;
        if (hipGetDevice(&dev) != hipSuccess || hipDeviceGetAttribute(&cus, hipDeviceAttributeMultiprocessorCount, dev) != hipSuccess) { grid = -1; return; }
        if (hipFuncSetAttribute((const void*)hybrid_fwd, hipFuncAttributeMaxDynamicSharedMemorySize, LDS_BYTES) != hipSuccess) { fprintf(stderr, "kernel_launch: hipFuncSetAttribute failed\n"); grid = -1; return; }
        if (hipOccupancyMaxActiveBlocksPerMultiprocessor(&per_cu, (const void*)hybrid_fwd, NWAVES * 64, LDS_BYTES) != hipSuccess || per_cu < 1) { fprintf(stderr, "kernel_launch: occupancy query reports %d\n", per_cu); per_cu = 1; }
        (void)hipGetLastError();
        grid = cus;
    }
    if (grid < 0) return;
    if (hipMemsetAsync((char*)d_ws + WS_CTL, 0, CTL_ZERO_BYTES, stream) != hipSuccess) { fprintf(stderr, "kernel_launch: hipMemsetAsync failed\n"); return; }
    Args a{};
    a.x = (const float*)d_in[0]; a.mem = (const float*)d_in[1]; a.g_pre = (const float*)d_in[2]; a.w_in = (const float*)d_in[3]; a.conv_w = (const float*)d_in[4]; a.conv_b = (const float*)d_in[5];
    a.w_lru_r = (const float*)d_in[6]; a.b_lru_r = (const float*)d_in[7]; a.w_lru_i = (const float*)d_in[8]; a.b_lru_i = (const float*)d_in[9]; a.lru_lambda = (const float*)d_in[10]; a.b_forget = (const float*)d_in[11];
    a.g_mem = (const float*)d_in[12]; a.w_mem_k = (const float*)d_in[13]; a.w_mem_v = (const float*)d_in[14]; a.w_branch = (const float*)d_in[15]; a.b_merge = (const float*)d_in[16]; a.w_out = (const float*)d_in[17]; a.g_post = (const float*)d_in[18];
    a.out = (float*)d_out; a.ws = (unsigned char*)d_ws;
    void* kargs[] = {&a};
    const hipError_t le = hipLaunchCooperativeKernel((const void*)hybrid_fwd, dim3(grid), dim3(NWAVES * 64), kargs, LDS_BYTES, stream);
    if (le != hipSuccess) fprintf(stderr, "kernel_launch: cooperative launch failed: %s (grid %d)\n", hipGetErrorName(le), grid);
}
```

```cpp
#include <hip/hip_runtime.h>
#include <hip/hip_cooperative_groups.h>
#include <hip/hip_bf16.h>
#include <cstdio>
#include <cstdint>
#include <cmath>
namespace cg = cooperative_groups;

constexpr int NB = 8, T = 8192, D = 1024, MTOK = NB * T;
constexpr int CHB = 2, MC = CHB * T, NCHUNK = NB / CHB;
constexpr int IN_COLS = 11280;
constexpr int LDZ = 11264, NZT = 44, NIN = 11520;
constexpr int ZC_AX = 0, ZC_GA = 1024, ZC_Q = 2048, ZC_K = 3072, ZC_V = 4096, ZC_GF = 5120, ZC_MQ = 6144, ZC_GM = 7168, ZC_MG = 8192;
constexpr int MEMLEN = 256;
constexpr float RMS_EPS = 1e-6f;
constexpr float LOG2E = 1.4426950408889634f;

namespace pg8 {
#define PG8_LAS __attribute__((address_space(3)))
typedef unsigned short bf16_t;
typedef short bf16x8 __attribute__((ext_vector_type(8)));
typedef float f32x4 __attribute__((ext_vector_type(4)));
typedef unsigned u32x4 __attribute__((ext_vector_type(4)));
constexpr int BM = 256, BK = 64, HALF = 128, HTB = HALF * BK * 2, STAGE_BYTES = 8 * HTB, NXCD = 8, WGM = 8;

__host__ __device__ __forceinline__ int lds_byte(int r, int c) { const int st = (r >> 4) * 2 + (c >> 5), rr = r & 15, cc = c & 31, ob = rr * 64 + cc * 2; return st * 1024 + (ob ^ (((ob >> 9) & 1) << 5)); }
__host__ __device__ __forceinline__ void stage_rc(int b, int& R, int& C) { const int st = b / 1024, sb = b % 1024, swz = sb ^ (((sb >> 9) & 1) << 5); R = (st >> 1) * 16 + swz / 64; C = (st & 1) * 32 + (swz % 64) / 2; }
__host__ __device__ __forceinline__ int perm32(int rho) { const int n = rho >> 4, i = rho & 15; return 8 * (i >> 2) + 4 * n + (i & 3); }

struct Unit { int pm, pn, z, ldo; const bf16_t* A; const bf16_t* B; bf16_t* O; const bf16_t* G; };
struct Gemm { int lda, ldb, K; };

struct TileOrder {
    int nM, nN, nwg, G, c;
    __device__ __forceinline__ void init(int nM_, int nN_, int G_, int c_) { nM = nM_; nN = nN_; nwg = nM * nN; G = G_; c = c_; }
    __device__ __forceinline__ bool map(int i, int& pm, int& pn) const {
        const long L = (long)i * G + c; if (L >= nwg) return false;
        int wgid = (int)L; { const int q = nwg / NXCD, r = nwg % NXCD, xcd = wgid % NXCD, off = wgid / NXCD; wgid = (xcd < r ? xcd * (q + 1) : r * (q + 1) + (xcd - r) * q) + off; }
        const int nig = WGM * nN, gid = wgid / nig, fm = gid * WGM, gsz = (nM - fm) < WGM ? (nM - fm) : WGM;
        pm = fm + ((wgid % nig) % gsz); pn = (wgid % nig) / gsz; return true;
    }
};

__device__ __forceinline__ unsigned cvt_pk_bf16(float lo, float hi) { unsigned r; asm volatile("v_cvt_pk_bf16_f32 %0, %1, %2" : "=v"(r) : "v"(lo), "v"(hi)); return r; }
__device__ __forceinline__ float bf_lo(unsigned w) { return __builtin_bit_cast(float, w << 16); }
__device__ __forceinline__ float bf_hi(unsigned w) { return __builtin_bit_cast(float, w & 0xffff0000u); }
__device__ __forceinline__ float sigm(float x) { return __builtin_amdgcn_rcpf(1.f + __expf(-x)); }

template <class Epi, class Sched>
__device__ __forceinline__ void gemm_phase(PG8_LAS unsigned char* lds, const Gemm g, const Sched& S, const Epi& E) {
    int tid_ = threadIdx.x; asm volatile("" : "+v"(tid_));
    const int tid = tid_, wid = __builtin_amdgcn_readfirstlane(tid >> 6), lane = tid & 63, wr = wid >> 2, wc = wid & 3, fr = lane & 15, fq = lane >> 4;
    const int K = g.K, nt = K / BK;
    unsigned voffA[2], voffB[2];
#pragma unroll
    for (int i = 0; i < 2; ++i) { int R, C; stage_rc(tid * 16 + i * 8192, R, C); const int Rb = (R & ~31) + perm32(R & 31);
        voffA[i] = (unsigned)(R * g.lda + C) * 2u; voffB[i] = (unsigned)(Rb * g.ldb + C) * 2u; }
    const size_t kstep = (size_t)(BK * 2);
    const size_t hstepA = (size_t)HALF * g.lda * 2, hstepB = (size_t)HALF * g.ldb * 2;
    const unsigned ldsw = (unsigned)wid * 1024u;
    const int aoff = lds_byte(wr * 64 + fr, fq * 8), boff = lds_byte(wc * 32 + fr, fq * 8);
#define PG8_SA(b, h) (((b) * 2 + (h)) * HTB)
#define PG8_SB(b, h) ((4 + (b) * 2 + (h)) * HTB)
#define PG8_STAGE(bufoff, gbase, voff) do { _Pragma("unroll") for (int _i = 0; _i < 2; ++_i) \
        __builtin_amdgcn_global_load_lds((const unsigned*)((const char*)(gbase) + (voff)[_i]), (PG8_LAS unsigned*)(lds + (bufoff) + ldsw + _i * 8192), 16, 0, 0); } while (0)
#define PG8_LDA(dst, b, h) do { _Pragma("unroll") for (int m = 0; m < 4; ++m) _Pragma("unroll") for (int k = 0; k < 2; ++k) dst[m][k] = *(const PG8_LAS bf16x8*)(lds + PG8_SA(b, h) + aoff + m * 2048 + k * 1024); } while (0)
#define PG8_LDB(dst, b, h) do { _Pragma("unroll") for (int n = 0; n < 2; ++n) _Pragma("unroll") for (int k = 0; k < 2; ++k) dst[n][k] = *(const PG8_LAS bf16x8*)(lds + PG8_SB(b, h) + boff + n * 2048 + k * 1024); } while (0)
#define PG8_MMA(ai, bj, At, Bt) do { __builtin_amdgcn_s_setprio(1); _Pragma("unroll") for (int m = 0; m < 4; ++m) _Pragma("unroll") for (int n = 0; n < 2; ++n) _Pragma("unroll") for (int k = 0; k < 2; ++k) \
        acc[ai][bj][m][n] = __builtin_amdgcn_mfma_f32_16x16x32_bf16(Bt[n][k], At[m][k], acc[ai][bj][m][n], 0, 0, 0); __builtin_amdgcn_s_setprio(0); } while (0)
#define PG8_WAIT_V(n) asm volatile("s_waitcnt vmcnt(" #n ")" ::: "memory")
#define PG8_WAIT_L(n) asm volatile("s_waitcnt lgkmcnt(" #n ")" ::: "memory")
#define PG8_BAR __builtin_amdgcn_s_barrier()
#define PG8_SCHED __builtin_amdgcn_sched_barrier(0)
    Unit cur, nxt; int ui = 0;
    if (!S.next(0, cur)) return;
    f32x4 acc[2][2][4][2];
#pragma unroll
    for (int a = 0; a < 2; ++a)
#pragma unroll
        for (int b = 0; b < 2; ++b)
#pragma unroll
            for (int m = 0; m < 4; ++m)
#pragma unroll
                for (int n = 0; n < 2; ++n) acc[a][b][m][n] = (f32x4){0.f, 0.f, 0.f, 0.f};
    bf16x8 At[4][2], B0[2][2], B1[2][2];
    const char* cA = (const char*)cur.A; const char* cB = (const char*)cur.B;
    PG8_STAGE(PG8_SB(0, 0), cB, voffB); PG8_STAGE(PG8_SB(0, 1), cB + hstepB, voffB); PG8_STAGE(PG8_SA(0, 0), cA, voffA); PG8_STAGE(PG8_SA(0, 1), cA + hstepA, voffA);
    if (wr == 1) PG8_BAR;
    PG8_WAIT_V(2); PG8_BAR;
    PG8_STAGE(PG8_SB(1, 0), cB + kstep, voffB); PG8_STAGE(PG8_SA(1, 0), cA + kstep, voffA); PG8_STAGE(PG8_SB(1, 1), cB + hstepB + kstep, voffB);
    PG8_WAIT_V(6); PG8_BAR;
    for (;;) {
        const bool has_next = S.next(ui + 1, nxt);
        const char* nA = has_next ? (const char*)nxt.A : cA; const char* nB = has_next ? (const char*)nxt.B : cB;
        for (int t = 0; t < nt; t += 2) {
            const bool last = (t == nt - 2);
            const char* a1 = cA + (size_t)(t + 1) * kstep;
            const char* a2 = last ? nA : cA + (size_t)(t + 2) * kstep; const char* b2 = last ? nB : cB + (size_t)(t + 2) * kstep;
            const char* a3 = a2 + kstep; const char* b3 = b2 + kstep;
            PG8_LDB(B0, 0, 0); PG8_LDB(B1, 0, 1); PG8_SCHED; PG8_LDA(At, 0, 0); PG8_STAGE(PG8_SA(1, 1), a1 + hstepA, voffA);
            PG8_WAIT_V(8); PG8_WAIT_L(0); PG8_BAR; PG8_MMA(0, 0, At, B0); PG8_MMA(0, 1, At, B1); PG8_BAR; PG8_SCHED;
            PG8_LDA(At, 0, 1); PG8_STAGE(PG8_SB(0, 0), b2, voffB); PG8_STAGE(PG8_SB(0, 1), b2 + hstepB, voffB); PG8_STAGE(PG8_SA(0, 0), a2, voffA);
            PG8_WAIT_V(8); PG8_WAIT_L(0); PG8_BAR; PG8_MMA(1, 0, At, B0); PG8_MMA(1, 1, At, B1); PG8_BAR; PG8_SCHED;
            PG8_LDB(B0, 1, 0); PG8_LDB(B1, 1, 1); PG8_SCHED; PG8_LDA(At, 1, 0); PG8_STAGE(PG8_SA(0, 1), a2 + hstepA, voffA);
            PG8_WAIT_V(8); PG8_WAIT_L(0); PG8_BAR; PG8_MMA(0, 0, At, B0); PG8_MMA(0, 1, At, B1); PG8_BAR; PG8_SCHED;
            PG8_LDA(At, 1, 1); PG8_STAGE(PG8_SB(1, 0), b3, voffB); PG8_STAGE(PG8_SB(1, 1), b3 + hstepB, voffB); PG8_STAGE(PG8_SA(1, 0), a3, voffA);
            PG8_WAIT_V(8); PG8_WAIT_L(0); PG8_BAR; PG8_MMA(1, 0, At, B0); PG8_MMA(1, 1, At, B1); PG8_BAR; PG8_SCHED;
        }
        if (wr == 0) PG8_BAR;
        E(acc, cur, wr, wc, fr, fq);
        if (!has_next) break;
#pragma unroll
        for (int a = 0; a < 2; ++a)
#pragma unroll
            for (int b = 0; b < 2; ++b)
#pragma unroll
                for (int m = 0; m < 4; ++m)
#pragma unroll
                    for (int n = 0; n < 2; ++n) acc[a][b][m][n] = (f32x4){0.f, 0.f, 0.f, 0.f};
        cur = nxt; cA = nA; cB = nB; ++ui;
        if (wr == 1) PG8_BAR;
    }
    PG8_WAIT_V(0);
    PG8_BAR;
#undef PG8_SA
#undef PG8_SB
#undef PG8_STAGE
#undef PG8_LDA
#undef PG8_LDB
#undef PG8_MMA
#undef PG8_WAIT_V
#undef PG8_WAIT_L
#undef PG8_SCHED
}

__device__ __forceinline__ float shx(float v, int lane, int m) { return __builtin_bit_cast(float, __builtin_amdgcn_ds_bpermute((lane ^ m) << 2, __builtin_bit_cast(int, v))); }
__device__ __forceinline__ u32x4 pack8(const f32x4 v0, const f32x4 v1) { u32x4 w; w.x = cvt_pk_bf16(v0[0], v0[1]); w.y = cvt_pk_bf16(v0[2], v0[3]); w.z = cvt_pk_bf16(v1[0], v1[1]); w.w = cvt_pk_bf16(v1[2], v1[3]); return w; }
__device__ __forceinline__ void unpack8(const u32x4 w, f32x4& v0, f32x4& v1) { v0[0] = bf_lo(w.x); v0[1] = bf_hi(w.x); v0[2] = bf_lo(w.y); v0[3] = bf_hi(w.y); v1[0] = bf_lo(w.z); v1[1] = bf_hi(w.z); v1[2] = bf_lo(w.w); v1[3] = bf_hi(w.w); }

struct EpiIn {
    const float* b_merge; const float* b_forget; float* LFt; int tok0;
    unsigned* NRM;
    __device__ __forceinline__ void operator()(f32x4 (&acc)[2][2][4][2], const Unit& u, int wr, int wc, int fr, int fq) const {
        asm volatile("" : "+v"(fr), "+v"(fq));
        const int lane_ = fq * 16 + fr; (void)lane_;
        const int pn = u.pn;
        if (pn < NZT) {
            const int kind = ((pn >= 4 && pn < 8) || (pn >= 20 && pn < 24) || (pn >= 28 && pn < 32)) ? 1 : (pn >= 8 && pn < 12) ? 2 : (pn >= 32) ? 3 : 0;
            bf16_t* base = u.O + (size_t)(wr * 64 + fr) * LDZ + wc * 32 + 8 * fq;
            f32x4 bv[2][2];
#pragma unroll
            for (int bj = 0; bj < 2; ++bj)
#pragma unroll
                for (int n = 0; n < 2; ++n) bv[bj][n] = (kind == 3) ? *(const f32x4*)(b_merge + (pn * 256 - ZC_MG) + wc * 32 + 8 * fq + bj * HALF + 4 * n) : (f32x4){0.f, 0.f, 0.f, 0.f};
#pragma unroll
            for (int ai = 0; ai < 2; ++ai)
#pragma unroll
                for (int m = 0; m < 4; ++m) { bf16_t* rowp = base + (size_t)(ai * HALF + m * 16) * LDZ;
#pragma unroll
                    for (int bj = 0; bj < 2; ++bj) { f32x4 v0 = acc[ai][bj][m][0], v1 = acc[ai][bj][m][1];
                        if (kind == 1) {
#pragma unroll
                            for (int e = 0; e < 4; ++e) { v0[e] = v0[e] * sigm(v0[e]); v1[e] = v1[e] * sigm(v1[e]); } }
                        else if (kind == 2) { v0 = v0 * (0.125f * LOG2E); v1 = v1 * (0.125f * LOG2E); }
                        else if (kind == 3) {
#pragma unroll
                            for (int e = 0; e < 4; ++e) { v0[e] = sigm(v0[e] + bv[bj][0][e]); v1[e] = sigm(v1[e] + bv[bj][1][e]); } }
                        *(u32x4*)(rowp + bj * HALF) = pack8(v0, v1); } }
            if (pn >= 8 && pn < 16) {
                const float sc2 = (pn < 12) ? (0.125f * LOG2E) * (0.125f * LOG2E) : 1.f;
                const int tokb = tok0 + u.pm * BM, bg = tokb >> 13, qb = (tokb & (T - 1)) >> 8;
#pragma unroll
                for (int bj = 0; bj < 2; ++bj) { float mx = 0.f;
#pragma unroll
                    for (int ai = 0; ai < 2; ++ai)
#pragma unroll
                        for (int m = 0; m < 4; ++m) { const f32x4 v0 = acc[ai][bj][m][0], v1 = acc[ai][bj][m][1];
                            float q = (v0[0] * v0[0] + v0[1] * v0[1]) + (v0[2] * v0[2] + v0[3] * v0[3]) + (v1[0] * v1[0] + v1[1] * v1[1]) + (v1[2] * v1[2] + v1[3] * v1[3]);
                            q += shx(q, lane_, 16); q += shx(q, lane_, 32); mx = fmaxf(mx, q); }
                    mx = fmaxf(mx, shx(mx, lane_, 1)); mx = fmaxf(mx, shx(mx, lane_, 2)); mx = fmaxf(mx, shx(mx, lane_, 4)); mx = fmaxf(mx, shx(mx, lane_, 8));
                    if (lane_ == 0) { const int head = (pn & 3) * 4 + 2 * bj + (wc >> 1), half = wc & 1;
                        unsigned* w = (pn < 12) ? NRM + 1024 + ((bg * 16 + head) * 32 + qb) * 2 + half : NRM + (bg * 16 + head) * 2 + half;
                        __hip_atomic_fetch_max(w, __builtin_bit_cast(unsigned, mx * sc2 * 1.02f), __ATOMIC_RELAXED, __HIP_MEMORY_SCOPE_AGENT); } }
            }
        } else {
            if (wc == 0 && fq < 2) {
#pragma unroll
                for (int ai = 0; ai < 2; ++ai)
#pragma unroll
                    for (int m = 0; m < 4; ++m) { const int tok = tok0 + u.pm * BM + ai * HALF + wr * 64 + m * 16 + fr; const int bg = tok >> 13, t = tok & (T - 1);
#pragma unroll
                        for (int n = 0; n < 2; ++n)
#pragma unroll
                            for (int e = 0; e < 4; ++e) { const int h = 8 * fq + 4 * n + e; const float x = acc[ai][0][m][n][e] + b_forget[h];
                                const float ls = fminf(x, 0.f) - log1pf(__expf(-fabsf(x)));
                                LFt[(size_t)(bg * 16 + h) * T + t] = ls; } }
            }
        }
    }
};
struct EpiStore {
    __device__ __forceinline__ void operator()(f32x4 (&acc)[2][2][4][2], const Unit& u, int wr, int wc, int fr, int fq) const {
        asm volatile("" : "+v"(fr), "+v"(fq));
        const int lane_ = fq * 16 + fr; (void)lane_;
        bf16_t* base = u.O + (size_t)(wr * 64 + fr) * u.ldo + wc * 32 + 8 * fq;
#pragma unroll
        for (int ai = 0; ai < 2; ++ai)
#pragma unroll
            for (int m = 0; m < 4; ++m) { bf16_t* rowp = base + (size_t)(ai * HALF + m * 16) * u.ldo;
#pragma unroll
                for (int bj = 0; bj < 2; ++bj) *(u32x4*)(rowp + bj * HALF) = pack8(acc[ai][bj][m][0], acc[ai][bj][m][1]); }
    }
};
struct EpiSoftmax {
    PG8_LAS float* xs;
    __device__ __forceinline__ void operator()(f32x4 (&acc)[2][2][4][2], const Unit& u, int wr, int wc, int fr, int fq) const {
        asm volatile("" : "+v"(fr), "+v"(fq));
        const int lane_ = fq * 16 + fr; (void)lane_;
        const float sc = 0.0625f * LOG2E;
        float lm[2][4];
#pragma unroll
        for (int ai = 0; ai < 2; ++ai)
#pragma unroll
            for (int m = 0; m < 4; ++m) {
                float mx = -INFINITY;
#pragma unroll
                for (int bj = 0; bj < 2; ++bj)
#pragma unroll
                    for (int n = 0; n < 2; ++n)
#pragma unroll
                        for (int e = 0; e < 4; ++e) mx = fmaxf(mx, acc[ai][bj][m][n][e]);
                mx = fmaxf(mx, shx(mx, lane_, 16)); mx = fmaxf(mx, shx(mx, lane_, 32)); mx *= sc;
                float s = 0.f;
#pragma unroll
                for (int bj = 0; bj < 2; ++bj)
#pragma unroll
                    for (int n = 0; n < 2; ++n)
#pragma unroll
                        for (int e = 0; e < 4; ++e) { const float p = __builtin_amdgcn_exp2f(acc[ai][bj][m][n][e] * sc - mx); acc[ai][bj][m][n][e] = p; s += p; }
                s += shx(s, lane_, 16); s += shx(s, lane_, 32);
                lm[ai][m] = mx;
                if (fq == 0) { const int row = ai * HALF + wr * 64 + m * 16 + fr; xs[(row * 4 + wc) * 2] = mx; xs[(row * 4 + wc) * 2 + 1] = s; }
            }
        asm volatile("s_waitcnt lgkmcnt(0)" ::: "memory"); PG8_BAR; asm volatile("" ::: "memory");
        bf16_t* base = u.O + (size_t)(wr * 64 + fr) * u.ldo + wc * 32 + 8 * fq;
#pragma unroll
        for (int ai = 0; ai < 2; ++ai)
#pragma unroll
            for (int m = 0; m < 4; ++m) { const int row = ai * HALF + wr * 64 + m * 16 + fr;
                const f32x4 a = *(const PG8_LAS f32x4*)(xs + row * 8), b = *(const PG8_LAS f32x4*)(xs + row * 8 + 4);
                const float M = fmaxf(fmaxf(a[0], a[2]), fmaxf(b[0], b[2]));
                const float tot = a[1] * __builtin_amdgcn_exp2f(a[0] - M) + a[3] * __builtin_amdgcn_exp2f(a[2] - M) + b[1] * __builtin_amdgcn_exp2f(b[0] - M) + b[3] * __builtin_amdgcn_exp2f(b[2] - M);
                const float f = __builtin_amdgcn_exp2f(lm[ai][m] - M) * __builtin_amdgcn_rcpf(tot);
                bf16_t* rowp = base + (size_t)(ai * HALF + m * 16) * u.ldo;
#pragma unroll
                for (int bj = 0; bj < 2; ++bj) *(u32x4*)(rowp + bj * HALF) = pack8(acc[ai][bj][m][0] * f, acc[ai][bj][m][1] * f); }
    }
};
struct EpiMul {
    __device__ __forceinline__ void operator()(f32x4 (&acc)[2][2][4][2], const Unit& u, int wr, int wc, int fr, int fq) const {
        asm volatile("" : "+v"(fr), "+v"(fq));
        const int lane_ = fq * 16 + fr; (void)lane_;
        const size_t lo = (size_t)(wr * 64 + fr) * LDZ + wc * 32 + 8 * fq;
#pragma unroll
        for (int ai = 0; ai < 2; ++ai)
#pragma unroll
            for (int m = 0; m < 4; ++m) { const size_t ro = lo + (size_t)(ai * HALF + m * 16) * LDZ;
#pragma unroll
                for (int bj = 0; bj < 2; ++bj) { const u32x4 gw = *(const u32x4*)(u.G + ro + bj * HALF); f32x4 g0, g1; unpack8(gw, g0, g1);
                    *(u32x4*)(u.O + ro + bj * HALF) = pack8(acc[ai][bj][m][0] * g0, acc[ai][bj][m][1] * g1); } }
    }
};
struct EpiMerge {
    __device__ __forceinline__ void operator()(f32x4 (&acc)[2][2][4][2], const Unit& u, int wr, int wc, int fr, int fq) const {
        asm volatile("" : "+v"(fr), "+v"(fq));
        const int lane_ = fq * 16 + fr; (void)lane_;
        const size_t lo = (size_t)(wr * 64 + fr) * LDZ + wc * 32 + 8 * fq;
#pragma unroll
        for (int ai = 0; ai < 2; ++ai)
#pragma unroll
            for (int m = 0; m < 4; ++m) { const size_t ro = lo + (size_t)(ai * HALF + m * 16) * LDZ;
#pragma unroll
                for (int bj = 0; bj < 2; ++bj) { const u32x4 gw = *(const u32x4*)(u.G + ro + bj * HALF); f32x4 g0, g1; unpack8(gw, g0, g1);
                    f32x4 v0 = acc[ai][bj][m][0] * g0, v1 = acc[ai][bj][m][1] * g1;
                    if (u.z > 0) { const u32x4 pw = *(const u32x4*)(u.O + ro + bj * HALF); f32x4 p0, p1; unpack8(pw, p0, p1); v0 = v0 + p0; v1 = v1 + p1; }
                    *(u32x4*)(u.O + ro + bj * HALF) = pack8(v0, v1); } }
    }
};
struct EpiOut {
    float* SSP;
    __device__ __forceinline__ void operator()(f32x4 (&acc)[2][2][4][2], const Unit& u, int wr, int wc, int fr, int fq) const {
        asm volatile("" : "+v"(fr), "+v"(fq));
        const int lane_ = fq * 16 + fr; (void)lane_;
        bf16_t* base = u.O + (size_t)(wr * 64 + fr) * u.ldo + wc * 32 + 8 * fq;
#pragma unroll
        for (int ai = 0; ai < 2; ++ai)
#pragma unroll
            for (int m = 0; m < 4; ++m) { bf16_t* rowp = base + (size_t)(ai * HALF + m * 16) * u.ldo; float s = 0.f;
#pragma unroll
                for (int bj = 0; bj < 2; ++bj) { const f32x4 v0 = acc[ai][bj][m][0], v1 = acc[ai][bj][m][1];
                    s += (v0[0] * v0[0] + v0[1] * v0[1]) + (v0[2] * v0[2] + v0[3] * v0[3]) + (v1[0] * v1[0] + v1[1] * v1[1]) + (v1[2] * v1[2] + v1[3] * v1[3]);
                    *(u32x4*)(rowp + bj * HALF) = pack8(v0, v1); }
                s += shx(s, lane_, 16); s += shx(s, lane_, 32);
                if (fq == 0) SSP[(size_t)(u.z + ai * HALF + wr * 64 + m * 16 + fr) * 16 + u.pn * 4 + wc] = s; }
    }
};
#undef PG8_BAR
}

namespace attn_body {
using bf16=__hip_bfloat16;
using bf16x8=__attribute__((ext_vector_type(8)))short;
using s16x4=__attribute__((ext_vector_type(4)))short;
using f32x16=__attribute__((ext_vector_type(16)))float;
using f32x4=__attribute__((ext_vector_type(4)))float;
using u32x4=__attribute__((ext_vector_type(4)))unsigned;
constexpr int BATCH=CHB,NHEAD=16,SEQ=T,D=64,DM=LDZ;
constexpr int NW=8,QBLK=32,QB=QBLK*NW,KVBLK=64,NQB=SEQ/QB;
__device__ __forceinline__ int crow(int r,int hi){return (r&3)+8*(r>>2)+4*hi;}
#define SBAR() __builtin_amdgcn_sched_barrier(0)
__device__ __forceinline__ void cmask(f32x16&p0,f32x16&p1,int jb,int qrel,int hi){
  const float NEG=-INFINITY; int kb=64*jb+4*hi;
  #pragma unroll
  for(int r=0;r<16;++r){int kv=kb+(r&3)+8*(r>>2); if(kv>qrel)p0[r]=NEG; if(kv+32>qrel)p1[r]=NEG;}
}
constexpr int NSLOT=3, SLOTB=8192;
constexpr int LDS_K=0, LDS_V=NSLOT*SLOTB, LDS_WS=2*NSLOT*SLOTB, LDS_OST=LDS_WS+NW*64*4, LDS_BIAS=LDS_OST+NW*4096, LDS_BYTES=LDS_BIAS+SEQ*4;
__device__ __forceinline__ void glds16(const void*gsrc,unsigned lds_dst){unsigned keep;
  asm volatile("s_mov_b32 %0, m0\n\ts_mov_b32 m0, %2\n\ts_nop 0\n\tglobal_load_lds_dwordx4 %1, off\n\ts_mov_b32 m0, %0":"=&s"(keep):"v"(gsrc),"s"(lds_dst):"memory");}
__device__ __forceinline__ float max3f(float a,float b,float c){float r;asm("v_max3_f32 %0, %1, %2, %3":"=v"(r):"v"(a),"v"(b),"v"(c));return r;}
__device__ __forceinline__ float max2f(float a,float b){float r;asm("v_max_f32_e32 %0, %1, %2":"=v"(r):"v"(a),"v"(b));return r;}
__device__ __forceinline__ float fadd_s(float a,float b){float r;asm("v_add_f32_e32 %0, %1, %2":"=v"(r):"v"(a),"v"(b));return r;}
__device__ __forceinline__ float fsub_s(float a,float b){float r;asm("v_sub_f32_e32 %0, %1, %2":"=v"(r):"v"(a),"v"(b));return r;}
typedef float f32x2_t __attribute__((ext_vector_type(2))); typedef __bf16 bf16x2_t __attribute__((ext_vector_type(2)));
__device__ __forceinline__ unsigned cvtpk_s(float lo,float hi){f32x2_t v={lo,hi};bf16x2_t b=__builtin_convertvector(v,bf16x2_t);return __builtin_bit_cast(unsigned,b);}
#define WAIT_BAR(N) asm volatile("s_waitcnt vmcnt(" #N ") lgkmcnt(0)\n\ts_barrier":::"memory")
typedef __attribute__((address_space(3))) const char* lds_cptr;
typedef short v4i16_t __attribute__((ext_vector_type(4)));
__device__ __forceinline__ void cinit(f32x16&c0,f32x16&c1,lds_cptr bp,int hi,float negmh){
  #pragma unroll
  for(int g=0;g<4;++g){
    const f32x4 b0=*(const __attribute__((address_space(3))) f32x4*)(bp+(8*g+4*hi)*4);
    const f32x4 b1=*(const __attribute__((address_space(3))) f32x4*)(bp+(32+8*g+4*hi)*4);
    #pragma unroll
    for(int e=0;e<4;++e){c0[4*g+e]=b0[e]+negmh;c1[4*g+e]=b1[e]+negmh;}}
}
__device__ __forceinline__ void qkt(f32x16&p0,f32x16&p1,const char*Kslot,const bf16x8*qr,int r32,int hi){
  const char*kb=Kslot+hi*1024+r32*16;
  #pragma unroll
  for(int d0=0;d0<4;++d0){
    const bf16x8 b0=*reinterpret_cast<const bf16x8*>(kb+d0*2048);
    const bf16x8 b1=*reinterpret_cast<const bf16x8*>(kb+d0*2048+512);
    p0=__builtin_amdgcn_mfma_f32_32x32x16_bf16(b0,qr[d0],p0,0,0,0);p1=__builtin_amdgcn_mfma_f32_32x32x16_bf16(b1,qr[d0],p1,0,0,0);}
}
__device__ __forceinline__ void kload8(bf16x8*kf,lds_cptr kp){
  kf[0]=*(const __attribute__((address_space(3))) bf16x8*)(kp);      kf[1]=*(const __attribute__((address_space(3))) bf16x8*)(kp+512);
  kf[2]=*(const __attribute__((address_space(3))) bf16x8*)(kp+2048); kf[3]=*(const __attribute__((address_space(3))) bf16x8*)(kp+2560);
  kf[4]=*(const __attribute__((address_space(3))) bf16x8*)(kp+4096); kf[5]=*(const __attribute__((address_space(3))) bf16x8*)(kp+4608);
  kf[6]=*(const __attribute__((address_space(3))) bf16x8*)(kp+6144); kf[7]=*(const __attribute__((address_space(3))) bf16x8*)(kp+6656);
}
__device__ __forceinline__ void kload2(bf16x8*kf,lds_cptr kp,int j){ kf[2*j]=*(const __attribute__((address_space(3))) bf16x8*)(kp+j*2048); kf[2*j+1]=*(const __attribute__((address_space(3))) bf16x8*)(kp+j*2048+512); }
__device__ __forceinline__ s16x4 vtr(lds_cptr p){ return __builtin_bit_cast(s16x4,__builtin_amdgcn_ds_read_tr16_b64_v4i16((__attribute__((address_space(3))) v4i16_t*)p)); }
__device__ __forceinline__ float rowmax(const f32x16&p0,const f32x16&p1){
  float a=max3f(p0[0],p0[1],p1[0]),b=max3f(p0[2],p0[3],p1[1]);a=max3f(a,p1[2],p1[3]);
  #pragma unroll
  for(int r=4;r<16;r+=4){a=max3f(a,p0[r],p0[r+1]);b=max3f(b,p0[r+2],p0[r+3]);a=max3f(a,p1[r],p1[r+1]);b=max3f(b,p1[r+2],p1[r+3]);}
  const float m=max2f(a,b);
  auto rr=__builtin_amdgcn_permlane32_swap(__float_as_uint(m),__float_as_uint(m),false,false);
  return max2f(__uint_as_float(rr[0]),__uint_as_float(rr[1]));
}
__device__ __forceinline__ void pv(f32x16*o,int vb,bf16x8 pa0,bf16x8 pa1,bf16x8 pa2,bf16x8 pa3){
  #pragma unroll
  for(int d0=0;d0<2;++d0){s16x4 lo[4],hi[4];
    #pragma unroll
    for(int ks=0;ks<4;++ks){
      asm volatile("ds_read_b64_tr_b16 %0,%1 offset:%c2":"=&v"(lo[ks]):"v"(vb),"i"(d0*4096+ks*1024):"memory");
      asm volatile("ds_read_b64_tr_b16 %0,%1 offset:%c2":"=&v"(hi[ks]):"v"(vb),"i"(d0*4096+ks*1024+512):"memory");}
    asm volatile("s_waitcnt lgkmcnt(0)":::"memory");SBAR();
    #define PK(k) (bf16x8){lo[k][0],lo[k][1],lo[k][2],lo[k][3],hi[k][0],hi[k][1],hi[k][2],hi[k][3]}
    o[d0]=__builtin_amdgcn_mfma_f32_32x32x16_bf16(pa0,PK(0),o[d0],0,0,0);
    o[d0]=__builtin_amdgcn_mfma_f32_32x32x16_bf16(pa1,PK(1),o[d0],0,0,0);
    o[d0]=__builtin_amdgcn_mfma_f32_32x32x16_bf16(pa2,PK(2),o[d0],0,0,0);
    o[d0]=__builtin_amdgcn_mfma_f32_32x32x16_bf16(pa3,PK(3),o[d0],0,0,0);
    #undef PK
  }
}
__device__ __forceinline__ u32x4 mul_bf16x8(u32x4 a,u32x4 b){
  u32x4 r;
  r.x=cvtpk_s(pg8::bf_lo(a.x)*pg8::bf_lo(b.x),pg8::bf_hi(a.x)*pg8::bf_hi(b.x)); r.y=cvtpk_s(pg8::bf_lo(a.y)*pg8::bf_lo(b.y),pg8::bf_hi(a.y)*pg8::bf_hi(b.y));
  r.z=cvtpk_s(pg8::bf_lo(a.z)*pg8::bf_lo(b.z),pg8::bf_hi(a.z)*pg8::bf_hi(b.z)); r.w=cvtpk_s(pg8::bf_lo(a.w)*pg8::bf_lo(b.w),pg8::bf_hi(a.w)*pg8::bf_hi(b.w));
  return r;
}

template<int THRL> __device__ __forceinline__ void attn_unit(int b,int h,int qb,const bf16*Q,const bf16*__restrict__ K,const bf16*__restrict__ V,bf16*O,const bf16*GF,const float*CBh,const unsigned*KN,const unsigned*QN,char*shm){
  int tid_=threadIdx.x; asm volatile("":"+v"(tid_));
  const int tid=tid_,lane=tid&63,r32=lane&31,hi=lane>>5; const int wid=__builtin_amdgcn_readfirstlane(tid>>6);
  const long rowbase=(long)b*SEQ; const int q0=qb*QB;
  const bf16*Qw=Q+(rowbase+q0+wid*QBLK)*DM+h*D;
  int t0=0;
  { const float k2=__uint_as_float(KN[0])+__uint_as_float(KN[1]), q2=__uint_as_float(QN[0])+__uint_as_float(QN[1]);
    const float smax=sqrtf(k2*q2); const float cutoff=CBh[q0]-40.f-2.f*smax; const int ntm4=(q0+QB)/KVBLK-4; int cnt=0;
    for(int base=0;base<ntm4;base+=64){ const int tt=base+lane; const bool skip=(tt<ntm4)&&(CBh[64*tt+63]<cutoff); cnt+=__popcll(__ballot(skip)); }
    t0=__builtin_amdgcn_readfirstlane(cnt)&~1; }
  const bf16*Kh=K+(rowbase+(long)t0*KVBLK)*DM+h*D,*Vh=V+(rowbase+(long)t0*KVBLK)*DM+h*D;
  const unsigned lds0=(unsigned)(uintptr_t)shm;
  float*wsf=(float*)(shm+LDS_WS)+wid*64;
  { const int n4=((q0+QB)>>2)-t0*16; f32x4*dst=(f32x4*)(shm+LDS_BIAS); const f32x4*src=(const f32x4*)CBh+t0*16;
    for(int i=tid;i<n4;i+=NW*64)dst[i]=src[i];
    asm volatile("s_waitcnt vmcnt(0)":::"memory"); }
  const bf16*ksrc=Kh+(long)lane*DM+wid*8;
  const bf16*vsrc=Vh+(long)(16*(wid&3)+(lane>>2))*DM+(wid>>2)*32+(lane&3)*8;
  const unsigned kdst=lds0+LDS_K+wid*1024, vdst=lds0+LDS_V+wid*1024;
  #define DMA_K(t,slot) glds16(ksrc+(long)(t)*KVBLK*DM,(unsigned)__builtin_amdgcn_readfirstlane(kdst+(slot)))
  #define DMA_V(t,slot) glds16(vsrc+(long)(t)*KVBLK*DM,(unsigned)__builtin_amdgcn_readfirstlane(vdst+(slot)))
  const int vb0=(int)(lds0+LDS_V)+((lane>>4)&1)*32+(lane&3)*8+(4*hi+((lane&15)>>2))*64;
  const char*Kbase=shm+LDS_K; bf16x8 kf[8];
  const lds_cptr shm3=(lds_cptr)shm; const lds_cptr kp0=shm3+LDS_K+hi*1024+r32*16; const lds_cptr vp0=shm3+LDS_V+((lane>>4)&1)*32+(lane&3)*8+(4*hi+((lane&15)>>2))*64;
  const lds_cptr bias0=shm3+LDS_BIAS;
  const int NT=(q0+QB)/KVBLK-t0;
  DMA_K(0,0);DMA_V(0,0);DMA_K(1,SLOTB);
  bf16x8 qr[4];
  #pragma unroll
  for(int d0=0;d0<4;++d0)qr[d0]=*reinterpret_cast<const bf16x8*>(&Qw[(long)r32*DM+d0*16+hi*8]);
  float mhat=0.f,l_reg=0.f;f32x16 o[2];o[0]=f32x16{};o[1]=f32x16{};
  const int qrel=wid*QBLK+r32;
  #define CMASK(P0,P1,t) do{int jb_=(t)-(NT-4); if(jb_>=0)cmask(P0,P1,jb_,qrel,hi);}while(0)
  bool resc=false;
  #define START(P0,P1) do{ const float rm=rowmax(P0,P1); resc=false; \
    { const float dl=rm; mhat=fadd_s(mhat,dl); \
      _Pragma("unroll") for(int r=0;r<16;++r){P0[r]=fsub_s(P0[r],dl);P1[r]=fsub_s(P1[r],dl);} } \
    _Pragma("unroll") for(int r=0;r<16;++r)P0[r]=__builtin_amdgcn_exp2f(P0[r]); }while(0)
  #define RESC() do{ if(resc){ asm volatile("s_waitcnt lgkmcnt(0)":::"memory"); \
      _Pragma("unroll") for(int d_=0;d_<2;++d_) _Pragma("unroll") for(int r=0;r<16;++r)o[d_][r]*=wsf[crow(r,hi)]; } }while(0)
  f32x16 pA0,pA1,pB0,pB1;
  int sl_prev=0,sl_cur=0,sl_next=SLOTB;
  #define ROT() do{sl_prev=sl_cur;sl_cur=sl_next;sl_next=(sl_next==(NSLOT-1)*SLOTB)?0:sl_next+SLOTB;}while(0)
  DMA_K(2,2*SLOTB);
  WAIT_BAR(3);
  cinit(pA0,pA1,bias0,hi,0.f);
  qkt(pA0,pA1,Kbase,qr,r32,hi);asm volatile("s_nop 15\n\ts_nop 7":"+v"(pA0),"+v"(pA1));CMASK(pA0,pA1,0);
  START(pA0,pA1);
  _Pragma("unroll") for(int r=0;r<16;++r)pA1[r]=__builtin_amdgcn_exp2f(pA1[r]);
  WAIT_BAR(0);
  DMA_K(3,0);DMA_V(1,SLOTB);
  ROT();
  kload8(kf,kp0+sl_cur);
  WAIT_BAR(2);
  s16x4 vlo[8],vhi[8]; u32x4 pw0,pw1,pw2,pw3;
  #define PKW(P,B) cvtpk_s(P[B],P[B+1])
  #define PAF(k) __builtin_bit_cast(bf16x8,pw##k)
  #define VFR(i) (bf16x8){vlo[i][0],vlo[i][1],vlo[i][2],vlo[i][3],vhi[i][0],vhi[i][1],vhi[i][2],vhi[i][3]}
  #define PIN(x) asm volatile("":"+v"(x))
  #define MX3(a,b,c) __builtin_fmaxf(__builtin_fmaxf((a),(b)),(c))
  #define GAPA(MF,A0,A1,A2,A3,W0,W1,PW) do{ MF; sacc+=A0; sacc+=A1; sacc+=A2; sacc+=A3; PIN(sacc); W0; W1; PIN(PW); SBAR(); }while(0)
  #define EX(v) __builtin_amdgcn_exp2f(v)
  #define GAPB(MF,X,B) do{ MF; X[B]=EX(X[B]); X[B+1]=EX(X[B+1]); X[B+2]=EX(X[B+2]); X[B+3]=EX(X[B+3]); PIN(X); SBAR(); }while(0)
  #define VRD(i) do{ vlo[i]=vtr(vp_+(((i)>>2)*4096+((i)&3)*1024)); vhi[i]=vtr(vp_+(((i)>>2)*4096+((i)&3)*1024+512)); }while(0)
  #define KRD(G,j) do{ if(G){ kload2(kf,kp0+sl_next,j); SBAR(); } }while(0)
  #define STEP(C0,C1,P0,P1,t,GK,GV,GL) do{ SBAR(); \
    const lds_cptr vp_=vp0+sl_prev; \
    cinit(C0,C1,bias0+(t)*256,hi,-mhat); SBAR(); \
    VRD(0); SBAR(); float sacc=(P0[0]+P0[1]); \
    GAPA(C0=__builtin_amdgcn_mfma_f32_32x32x16_bf16(kf[0],qr[0],C0,0,0,0), P0[2],P0[3],P0[4],P0[5],     pw0[0]=PKW(P0,0), pw0[1]=PKW(P0,2), pw0); \
    VRD(4); SBAR(); GAPA(C1=__builtin_amdgcn_mfma_f32_32x32x16_bf16(kf[1],qr[0],C1,0,0,0), P0[6],P0[7],P0[8],P0[9],     pw0[2]=PKW(P0,4), pw0[3]=PKW(P0,6), pw0); \
    VRD(1); SBAR(); GAPA(C0=__builtin_amdgcn_mfma_f32_32x32x16_bf16(kf[2],qr[1],C0,0,0,0),   P0[10],P0[11],P0[12],P0[13], pw1[0]=PKW(P0,8), pw1[1]=PKW(P0,10), pw1); \
    VRD(5); SBAR(); GAPA(C1=__builtin_amdgcn_mfma_f32_32x32x16_bf16(kf[3],qr[1],C1,0,0,0),   P0[14],P0[15],P1[0],P1[1],   pw1[2]=PKW(P0,12),pw1[3]=PKW(P0,14), pw1); \
    VRD(2); SBAR(); GAPA(C0=__builtin_amdgcn_mfma_f32_32x32x16_bf16(kf[4],qr[2],C0,0,0,0),   P1[2],P1[3],P1[4],P1[5],     pw2[0]=PKW(P1,0), pw2[1]=PKW(P1,2), pw2); \
    VRD(6); SBAR(); GAPA(C1=__builtin_amdgcn_mfma_f32_32x32x16_bf16(kf[5],qr[2],C1,0,0,0),   P1[6],P1[7],P1[8],P1[9],     pw2[2]=PKW(P1,4), pw2[3]=PKW(P1,6), pw2); \
    VRD(3); SBAR(); GAPA(C0=__builtin_amdgcn_mfma_f32_32x32x16_bf16(kf[6],qr[3],C0,0,0,0),   P1[10],P1[11],P1[12],P1[13], pw3[0]=PKW(P1,8), pw3[1]=PKW(P1,10), pw3); \
    VRD(7); SBAR(); GAPA(C1=__builtin_amdgcn_mfma_f32_32x32x16_bf16(kf[7],qr[3],C1,0,0,0),   P1[14],P1[15],0.f,0.f,       pw3[2]=PKW(P1,12),pw3[3]=PKW(P1,14), pw3); \
    l_reg+=sacc; \
    if(GK){DMA_K((t)+3,sl_cur);} if(GV){DMA_V((t)+1,sl_next);} \
    CMASK(C0,C1,t); \
    { float a=MX3(C0[0],C0[1],C1[0]),b=MX3(C0[2],C0[3],C1[1]); a=MX3(a,C1[2],C1[3]); \
      _Pragma("unroll") for(int r=4;r<16;r+=4){a=MX3(a,C0[r],C0[r+1]);b=MX3(b,C0[r+2],C0[r+3]);a=MX3(a,C1[r],C1[r+1]);b=MX3(b,C1[r+2],C1[r+3]);} \
      float rm=__builtin_fmaxf(a,b); { auto rr=__builtin_amdgcn_permlane32_swap(__float_as_uint(rm),__float_as_uint(rm),false,false); rm=__builtin_fmaxf(__uint_as_float(rr[0]),__uint_as_float(rr[1])); } \
      resc=false; \
      if(__builtin_expect(__any(rm>(float)THRL),0)){ const float dl=__builtin_fmaxf(rm,0.f); mhat+=dl; \
        _Pragma("unroll") for(int r=0;r<16;++r){C0[r]-=dl;C1[r]-=dl;} \
        const float f=__builtin_amdgcn_exp2f(-dl); l_reg*=f; if(hi==0)wsf[r32]=f; resc=true; } } \
    SBAR(); \
    GAPB(o[0]=__builtin_amdgcn_mfma_f32_32x32x16_bf16(PAF(0),VFR(0),o[0],0,0,0), C0,0); \
    GAPB(o[1]=__builtin_amdgcn_mfma_f32_32x32x16_bf16(PAF(0),VFR(4),o[1],0,0,0), C0,4); \
    KRD(GL,0); GAPB(o[0]=__builtin_amdgcn_mfma_f32_32x32x16_bf16(PAF(1),VFR(1),o[0],0,0,0), C0,8); \
    KRD(GL,1); GAPB(o[1]=__builtin_amdgcn_mfma_f32_32x32x16_bf16(PAF(1),VFR(5),o[1],0,0,0), C0,12); \
    KRD(GL,2); GAPB(o[0]=__builtin_amdgcn_mfma_f32_32x32x16_bf16(PAF(2),VFR(2),o[0],0,0,0), C1,0); \
    KRD(GL,3); GAPB(o[1]=__builtin_amdgcn_mfma_f32_32x32x16_bf16(PAF(2),VFR(6),o[1],0,0,0), C1,4); \
    GAPB(o[0]=__builtin_amdgcn_mfma_f32_32x32x16_bf16(PAF(3),VFR(3),o[0],0,0,0), C1,8); \
    GAPB(o[1]=__builtin_amdgcn_mfma_f32_32x32x16_bf16(PAF(3),VFR(7),o[1],0,0,0), C1,12); \
    }while(0)
  int t=1;
  #undef CMASK
  #define CMASK(P0,P1,t) do{}while(0)
  for(;t+5<NT;t+=2){
    STEP(pB0,pB1,pA0,pA1,t,true,true,true);     WAIT_BAR(2); RESC(); ROT();
    STEP(pA0,pA1,pB0,pB1,t+1,true,true,true);   WAIT_BAR(2); RESC(); ROT();
  }
  #undef CMASK
  #define CMASK(P0,P1,t) do{int jb_=(t)-(NT-4); if(jb_>=0)cmask(P0,P1,jb_,qrel,hi);}while(0)
  #define ENDW(tt) do{ if((tt)+3<NT){WAIT_BAR(2);} else if((tt)+2<NT){WAIT_BAR(1);} else {WAIT_BAR(0);} }while(0)
  for(;t+1<NT;t+=2){
    STEP(pB0,pB1,pA0,pA1,t,(t+3<NT),(t+1<NT),(t+1<NT));       ENDW(t);   RESC(); ROT();
    STEP(pA0,pA1,pB0,pB1,t+1,(t+4<NT),(t+2<NT),(t+2<NT));     ENDW(t+1); RESC(); ROT();
  }
  STEP(pB0,pB1,pA0,pA1,NT-1,false,false,false); RESC();
  { float sacc=pB0[0]+pB0[1]; _Pragma("unroll") for(int r=2;r<16;++r)sacc+=pB0[r]; _Pragma("unroll") for(int r=0;r<16;++r)sacc+=pB1[r]; l_reg+=sacc;
    pw0=(u32x4){PKW(pB0,0),PKW(pB0,2),PKW(pB0,4),PKW(pB0,6)};pw1=(u32x4){PKW(pB0,8),PKW(pB0,10),PKW(pB0,12),PKW(pB0,14)};pw2=(u32x4){PKW(pB1,0),PKW(pB1,2),PKW(pB1,4),PKW(pB1,6)};pw3=(u32x4){PKW(pB1,8),PKW(pB1,10),PKW(pB1,12),PKW(pB1,14)};
    SBAR(); pv(o,vb0+sl_cur,PAF(0),PAF(1),PAF(2),PAF(3)); }
  #undef PKW
  #undef PAF
  #undef VFR
  #undef PIN
  #undef MX3
  #undef GAPA
  #undef GAPB
  #undef EX
  #undef VRD
  #undef KRD
  #undef STEP
  #undef ENDW
  {auto rr=__builtin_amdgcn_permlane32_swap(__float_as_uint(l_reg),__float_as_uint(l_reg),false,false);l_reg=__uint_as_float(rr[0])+__uint_as_float(rr[1]);}
  if(hi==0)wsf[32+r32]=l_reg;asm volatile("s_waitcnt lgkmcnt(0)":::"memory");
  float rli[16];
  #pragma unroll
  for(int r=0;r<16;++r)rli[r]=__builtin_amdgcn_rcpf(wsf[32+crow(r,hi)]);
  bf16*Ow=O+(rowbase+q0+wid*QBLK)*DM+h*D;
  const bf16*Gw=GF+(rowbase+q0+wid*QBLK)*DM+h*D;
  { bf16*stg=(bf16*)(shm+LDS_OST)+wid*2048;
    #pragma unroll
    for(int r=0;r<16;++r){const int orow=crow(r,hi);
      #pragma unroll
      for(int d0=0;d0<2;++d0)stg[orow*64+d0*32+r32]=__float2bfloat16(o[d0][r]*rli[r]);}
    asm volatile("s_waitcnt lgkmcnt(0)":::"memory");
    #pragma unroll
    for(int i=0;i<4;++i){const int row=i*8+(lane>>3),ch=lane&7; const u32x4 v=*(const u32x4*)(stg+row*64+ch*8); const u32x4 gg=*(const u32x4*)(Gw+(long)row*DM+ch*8);
      *(u32x4*)(Ow+(long)row*DM+ch*8)=mul_bf16x8(v,gg);} }
  asm volatile("s_waitcnt vmcnt(0) lgkmcnt(0)\n\ts_barrier":::"memory");
  #undef DMA_K
  #undef DMA_V
  #undef CMASK
  #undef START
  #undef RESC
  #undef ROT
}
constexpr int ATTN_LDS_BYTES=LDS_BYTES;
#undef SBAR
#undef WAIT_BAR
}

constexpr int NWAVES = 8;
constexpr size_t MiB = 1u << 20;
constexpr size_t WS_CTL = 0, CTL_ZERO_BYTES = 1 * MiB;
constexpr size_t WS_WIN = 2 * MiB, WS_WK = 25 * MiB, WS_WV = 27 * MiB, WS_WB = 29 * MiB, WS_WO = 35 * MiB, WS_WRF = 37 * MiB, WS_COEF = 37 * MiB + 512 * 1024;
constexpr size_t WS_MN = 38 * MiB, WS_MK = 42 * MiB, WS_MVT = 46 * MiB, WS_CB = 50 * MiB, WS_AGG = 54 * MiB, WS_SSP = 56 * MiB;
constexpr size_t WS_XN = 60 * MiB, WS_OUTB = 188 * MiB, WS_Z = 316 * MiB, WS_END = 668 * MiB;
static_assert(WS_WIN + (size_t)NIN * D * 2 <= WS_WK && WS_SSP + (size_t)MTOK * 16 * 4 <= WS_XN && WS_XN + (size_t)MTOK * D * 2 <= WS_OUTB && WS_OUTB + (size_t)MTOK * D * 2 <= WS_Z && WS_Z + (size_t)MC * LDZ * 2 <= WS_END, "d_ws map");
constexpr int CW_BAR = 4096, CW_NRM = 16384;

constexpr int RING_OFF = 0, RING_BYTES = 131072;
constexpr int LDSCTL_OFF = RING_BYTES, MISC_OFF = LDSCTL_OFF + 320, XS_OFF = LDSCTL_OFF + 1024;
constexpr int LDS_BYTES = 147456;
static_assert(XS_OFF + 8192 <= LDS_BYTES && attn_body::ATTN_LDS_BYTES <= RING_BYTES, "LDS map");

#define GAS __attribute__((address_space(1)))
#define LAS __attribute__((address_space(3)))
typedef unsigned short bf16;
typedef unsigned v4u __attribute__((ext_vector_type(4)));
typedef unsigned v2u __attribute__((ext_vector_type(2)));
typedef float f32x4 __attribute__((ext_vector_type(4)));
typedef float f32x16 __attribute__((ext_vector_type(16)));
typedef short bf16x8 __attribute__((ext_vector_type(8)));
typedef GAS unsigned gu32;
#define LDS_WAIT() asm volatile("s_waitcnt lgkmcnt(0)" ::: "memory")
#define VM_WAIT() asm volatile("s_waitcnt vmcnt(0)" ::: "memory")
__device__ __forceinline__ unsigned f2bf(float f) { unsigned u = __builtin_bit_cast(unsigned, f); return (u + 0x7fffu + ((u >> 16) & 1u)) >> 16; }
__device__ __forceinline__ unsigned pk2(float lo, float hi) { return f2bf(lo) | (f2bf(hi) << 16); }

#define XB_TMO      128
#define XB_XCNT(j)  (256  + 64 * (j))
#define XB_XSUB(j)  (1280 + 64 * (j))
#define XB_XGEN(j)  (2304 + 64 * (j))
#define XB_TOP      3328
#define XB_TOPGEN   3392
#define XCD_BAR_WORDS 3456
#define XB_SPIN_CAP (1u << 22)
__device__ __forceinline__ unsigned xb_ld(unsigned* p)              { return __hip_atomic_load(p, __ATOMIC_RELAXED, __HIP_MEMORY_SCOPE_AGENT); }
__device__ __forceinline__ unsigned xb_add(unsigned* p, unsigned v) { return __hip_atomic_fetch_add(p, v, __ATOMIC_RELAXED, __HIP_MEMORY_SCOPE_AGENT); }
__device__ __forceinline__ unsigned xb_xcc_id() { return (unsigned)__builtin_amdgcn_s_getreg((3 << 11) | 20) & 0xFu; }
#define XB_SPIN(cond, bar) do { unsigned _sp = 0; while (cond) { __builtin_amdgcn_s_sleep(1); \
    if ((++_sp & 255u) == 0u) { if (xb_ld(&(bar)[XB_TMO])) break; if (_sp > XB_SPIN_CAP) { atomicAdd(&(bar)[XB_TMO], 1u); break; } } } } while (0)
struct XcdBarrier { unsigned* bar; unsigned x; volatile LAS unsigned* st; };
__device__ __forceinline__ XcdBarrier xcd_barrier_post(unsigned* bar, volatile LAS unsigned* st) {
    XcdBarrier b; b.bar = bar; b.x = xb_xcc_id(); b.st = st;
    if (threadIdx.x == 0) (void)xb_add(&bar[XB_XCNT(b.x)], 1u);
    return b;
}
__device__ __forceinline__ void xcd_barrier_complete(unsigned* bar, unsigned x, unsigned& nloc, unsigned& nx) {
    const unsigned G = gridDim.x * gridDim.y * gridDim.z;
    unsigned sum, cnt, mine, sp = 0u;
    for (;;) {
        sum = 0u; cnt = 0u; mine = 0u;
#pragma unroll
        for (unsigned j = 0; j < 16; ++j) { const unsigned c = xb_ld(&bar[XB_XCNT(j)]); sum += c; cnt += (c > 0u) ? 1u : 0u; mine = (j == x) ? c : mine; }
        if (sum == G) break;
        __builtin_amdgcn_s_sleep(1);
        if ((++sp & 255u) == 0u) { if (xb_ld(&bar[XB_TMO])) break; if (sp > XB_SPIN_CAP) { atomicAdd(&bar[XB_TMO], 1u); break; } }
    }
    nloc = mine > 0u ? mine : 1u; nx = cnt > 0u ? cnt : 1u;
}
__device__ __forceinline__ void xcd_barrier(const XcdBarrier& b) {
    asm volatile("s_waitcnt vmcnt(0)" ::: "memory");
    __syncthreads();
    if (threadIdx.x == 0) {
        unsigned* bar = b.bar;
        __builtin_amdgcn_s_waitcnt(0);
        unsigned nloc = b.st[0], nx = b.st[1];
        if (nloc == 0u) { xcd_barrier_complete(bar, b.x, nloc, nx); b.st[0] = nloc; b.st[1] = nx; }
        const unsigned old = xb_add(&bar[XB_XSUB(b.x)], 1u);
        const unsigned gen = old / nloc;
        if (old + 1u == (gen + 1u) * nloc) {
            __builtin_amdgcn_fence(__ATOMIC_RELEASE, "agent");
            asm volatile("s_waitcnt vmcnt(0)" ::: "memory");
            const unsigned og = xb_add(&bar[XB_TOP], 1u);
            const unsigned tg = og / nx;
            if (og + 1u == (tg + 1u) * nx) xb_add(&bar[XB_TOPGEN], 1u);
            else XB_SPIN(xb_ld(&bar[XB_TOPGEN]) == tg, bar);
            __builtin_amdgcn_fence(__ATOMIC_ACQUIRE, "agent");
            xb_add(&bar[XB_XGEN(b.x)], 1u);
            asm volatile("s_waitcnt vmcnt(0)" ::: "memory");
        } else {
            XB_SPIN(xb_ld(&bar[XB_XGEN(b.x)]) == gen, bar);
            __builtin_amdgcn_fence(__ATOMIC_ACQUIRE, "agent");
            asm volatile("s_waitcnt vmcnt(0)" ::: "memory");
        }
    }
    __syncthreads();
}

template <class T_> __device__ __forceinline__ T_* as_global(T_* p) { return (T_*)(GAS T_*)p; }
struct Args {
    const float *x, *mem, *g_pre, *w_in, *conv_w, *conv_b, *w_lru_r, *b_lru_r, *w_lru_i, *b_lru_i, *lru_lambda, *b_forget, *g_mem, *w_mem_k, *w_mem_v, *w_branch, *b_merge, *w_out, *g_post;
    float* out; unsigned char* ws;
};

__device__ __forceinline__ float wave_sum(float v) {
#pragma unroll
    for (int o = 1; o < 64; o <<= 1) v += __shfl_xor(v, o);
    return v;
}
__device__ __forceinline__ void p0_transpose_item(const float* W, int ld, int K, int ncols, bf16* WT, LAS float* scr, int item, int lane) {
    const int nblk = ncols / 32, kb = item / nblk, nb = item % nblk, k0 = 64 * kb, n0 = 32 * nb;
#pragma unroll 8
    for (int i = 0; i < 32; ++i) { const int kk = 2 * i + (lane >> 5); scr[kk * 33 + (lane & 31)] = W[(size_t)(k0 + kk) * ld + n0 + (lane & 31)]; }
    LDS_WAIT(); asm volatile("" ::: "memory");
    const int c = lane & 7;
#pragma unroll
    for (int j = 0; j < 4; ++j) { const int n = (lane >> 3) + 8 * j; const LAS float* s = scr + (8 * c) * 33 + n;
        v4u o; o.x = pk2(s[0 * 33], s[1 * 33]); o.y = pk2(s[2 * 33], s[3 * 33]); o.z = pk2(s[4 * 33], s[5 * 33]); o.w = pk2(s[6 * 33], s[7 * 33]);
        *(GAS v4u*)(WT + (size_t)(n0 + n) * K + k0 + 8 * c) = o; }
    LDS_WAIT(); asm volatile("" ::: "memory");
}
__device__ __forceinline__ void rms_row_to_bf16(const float* xrow, const float* g, bf16* orow, int lane) {
    const GAS f32x4* xr = (const GAS f32x4*)xrow + lane; const GAS f32x4* gr = (const GAS f32x4*)g + lane;
    f32x4 v[4]; float s = 0.f;
#pragma unroll
    for (int j = 0; j < 4; ++j) { v[j] = xr[64 * j]; s += (v[j].x * v[j].x + v[j].y * v[j].y) + (v[j].z * v[j].z + v[j].w * v[j].w); }
    const float rs = 1.f / sqrtf(wave_sum(s) * (1.f / D) + RMS_EPS);
    GAS unsigned long long* o8 = (GAS unsigned long long*)orow + lane;
#pragma unroll
    for (int j = 0; j < 4; ++j) { const f32x4 gg = gr[64 * j];
        o8[64 * j] = (unsigned long long)pk2(v[j].x * rs * gg.x, v[j].y * rs * gg.y) | ((unsigned long long)pk2(v[j].z * rs * gg.z, v[j].w * rs * gg.w) << 32); }
}

struct LruPtrs { const float *conv_w, *conv_b, *b_lru_r, *b_lru_i; unsigned char* ws; };
template <int PASS>
__device__ __forceinline__ void lru_unit(const LruPtrs& args, LAS unsigned char* lds, int chunk, int bl, int g, int ck) {
    int tid_ = threadIdx.x; asm volatile("" : "+v"(tid_));
    const int tid = tid_, lane = tid & 63, n = lane & 31, hi = lane >> 5; const int w = __builtin_amdgcn_readfirstlane(tid >> 6);
    unsigned char* ws = args.ws; asm volatile("" : "+s"(ws)); ws = as_global(ws);
    GAS bf16* Z = (GAS bf16*)(ws + WS_Z);
    GAS float* AGG = (GAS float*)(ws + WS_AGG);
    LAS float* WAG = (LAS float*)(lds + RING_OFF);
    LAS float* CARW = (LAS float*)(lds + RING_OFF + 8192);
    LAS float* PRM = (LAS float*)(lds + RING_OFF + 12288);
    { const float* src = (w < 4) ? args.conv_w + w * D : (w == 4) ? args.conv_b : (w == 5) ? args.b_lru_r : (w == 6) ? args.b_lru_i : (const float*)(ws + WS_COEF);
      PRM[w * 64 + lane] = ((const GAS float*)src)[g * 64 + lane]; }
    float pA = 1.f, pH = 0.f;
    if (PASS == 3) { typedef float f32x2v __attribute__((ext_vector_type(2))); f32x2v ag[4];
#pragma unroll
        for (int j = 0; j < 4; ++j) { const int cc = 4 * w + j; ag[j] = (f32x2v){1.f, 0.f}; if (cc < ck) ag[j] = *(const GAS f32x2v*)(AGG + ((size_t)(bl * 32 + cc) * D + g * 64 + lane) * 2); }
#pragma unroll
        for (int j = 0; j < 4; ++j) { pH = ag[j].x * pH + ag[j].y; pA = pA * ag[j].x; } }
    const int tl = ck * 256 + w * 32 + n;
    const size_t zr = (size_t)bl * T + tl;
    const int cb0 = g * 64 + 4 * hi;
    v2u xw[4][8];
#pragma unroll
    for (int k = 0; k < 4; ++k) {
        const int ts = tl - 3 + k; const bool ok = ts >= 0;
        const GAS bf16* rp = Z + (zr - 3 + k) * LDZ + ZC_AX + cb0;
#pragma unroll
        for (int q = 0; q < 8; ++q) { xw[k][q] = (v2u){0u, 0u}; if (ok) xw[k][q] = *(const GAS v2u*)(rp + 8 * q); }
    }
    __syncthreads();
    float xc[8][4];
#pragma unroll
    for (int q = 0; q < 8; ++q) { const f32x4 bb = *(const LAS f32x4*)(PRM + 4 * 64 + 8 * q + 4 * hi);
#pragma unroll
        for (int p = 0; p < 4; ++p) xc[q][p] = bb[p]; }
#pragma unroll
    for (int k = 0; k < 4; ++k) {
#pragma unroll
        for (int q = 0; q < 8; ++q) { const f32x4 cw = *(const LAS f32x4*)(PRM + k * 64 + 8 * q + 4 * hi);
            xc[q][0] += cw[0] * pg8::bf_lo(xw[k][q].x); xc[q][1] += cw[1] * pg8::bf_hi(xw[k][q].x); xc[q][2] += cw[2] * pg8::bf_lo(xw[k][q].y); xc[q][3] += cw[3] * pg8::bf_hi(xw[k][q].y); }
    }
    f32x16 ar[2], ai_[2];
#pragma unroll
    for (int rb = 0; rb < 2; ++rb) { ar[rb] = f32x16{}; ai_[rb] = f32x16{}; }
    const GAS bf16* wrf = (const GAS bf16*)(ws + WS_WRF) + (size_t)g * (2 * 2 * 4 * 64 * 8) + lane * 8;
#pragma unroll
    for (int ks = 0; ks < 4; ++ks) {
        v4u bw; bw.x = pg8::cvt_pk_bf16(xc[2 * ks][0], xc[2 * ks][1]); bw.y = pg8::cvt_pk_bf16(xc[2 * ks][2], xc[2 * ks][3]); bw.z = pg8::cvt_pk_bf16(xc[2 * ks + 1][0], xc[2 * ks + 1][1]); bw.w = pg8::cvt_pk_bf16(xc[2 * ks + 1][2], xc[2 * ks + 1][3]);
        const bf16x8 bfr = __builtin_bit_cast(bf16x8, bw);
#pragma unroll
        for (int rb = 0; rb < 2; ++rb) {
            const bf16x8 wr_ = __builtin_bit_cast(bf16x8, *(const GAS v4u*)(wrf + ((0 * 2 + rb) * 4 + ks) * 512));
            const bf16x8 wi_ = __builtin_bit_cast(bf16x8, *(const GAS v4u*)(wrf + ((1 * 2 + rb) * 4 + ks) * 512));
            ar[rb] = __builtin_amdgcn_mfma_f32_32x32x16_bf16(wr_, bfr, ar[rb], 0, 0, 0);
            ai_[rb] = __builtin_amdgcn_mfma_f32_32x32x16_bf16(wi_, bfr, ai_[rb], 0, 0, 0);
        }
    }
    float av[8][4], uv[8][4];
#pragma unroll
    for (int q = 0; q < 8; ++q) {
        const f32x4 br = *(const LAS f32x4*)(PRM + 5 * 64 + 8 * q + 4 * hi), bi = *(const LAS f32x4*)(PRM + 6 * 64 + 8 * q + 4 * hi), cf = *(const LAS f32x4*)(PRM + 7 * 64 + 8 * q + 4 * hi);
#pragma unroll
        for (int p = 0; p < 4; ++p) { const int rb = q >> 2, r = (q & 3) * 4 + p;
            const float rr = pg8::sigm(ar[rb][r] + br[p]), ii = pg8::sigm(ai_[rb][r] + bi[p]);
            const float a = __builtin_amdgcn_exp2f(cf[p] * rr);
            const float m2 = fmaxf(1.f - a * a, 0.f);
            av[q][p] = a; uv[q][p] = sqrtf(m2) * (ii * xc[q][p]); }
    }
#define LRU_DPP(oldv, v, ctrl, rmask) __builtin_bit_cast(float, __builtin_amdgcn_update_dpp(__builtin_bit_cast(int, (float)(oldv)), __builtin_bit_cast(int, (float)(v)), ctrl, rmask, 0xf, false))
#pragma unroll
    for (int q = 0; q < 8; ++q)
#pragma unroll
        for (int p = 0; p < 4; ++p) { float a = av[q][p], u = uv[q][p], ap, up;
            ap = LRU_DPP(1.f, a, 0x111, 0xf); up = LRU_DPP(0.f, u, 0x111, 0xf); u = a * up + u; a = a * ap;
            ap = LRU_DPP(1.f, a, 0x112, 0xf); up = LRU_DPP(0.f, u, 0x112, 0xf); u = a * up + u; a = a * ap;
            ap = LRU_DPP(1.f, a, 0x114, 0xf); up = LRU_DPP(0.f, u, 0x114, 0xf); u = a * up + u; a = a * ap;
            ap = LRU_DPP(1.f, a, 0x118, 0xf); up = LRU_DPP(0.f, u, 0x118, 0xf); u = a * up + u; a = a * ap;
            ap = LRU_DPP(1.f, a, 0x142, 0xa); up = LRU_DPP(0.f, u, 0x142, 0xa); u = a * up + u; a = a * ap;
            av[q][p] = a; uv[q][p] = u; }
#undef LRU_DPP
    if (n == 31) {
#pragma unroll
        for (int q = 0; q < 8; ++q)
#pragma unroll
            for (int p = 0; p < 4; ++p) { const int ci = 8 * q + 4 * hi + p; WAG[(w * 64 + ci) * 2] = av[q][p]; WAG[(w * 64 + ci) * 2 + 1] = uv[q][p]; }
    }
    LAS float* PART = (LAS float*)(lds + RING_OFF + 4096);
    if (PASS == 3) { PART[(w * 64 + lane) * 2] = pA; PART[(w * 64 + lane) * 2 + 1] = pH; }
    __syncthreads();
    if (PASS == 1) {
        if (w == 0) { float A = 1.f, H = 0.f;
#pragma unroll
            for (int ww = 0; ww < 8; ++ww) { const float a = WAG[(ww * 64 + lane) * 2], h = WAG[(ww * 64 + lane) * 2 + 1]; H = a * H + h; A = A * a; }
            GAS float* dst = AGG + ((size_t)(bl * 32 + ck) * D + g * 64 + lane) * 2; dst[0] = A; dst[1] = H; }
        __syncthreads();
    } else {
        if (w == 0) { float H = 0.f;
#pragma unroll
            for (int ww = 0; ww < 8; ++ww) H = PART[(ww * 64 + lane) * 2] * H + PART[(ww * 64 + lane) * 2 + 1];
#pragma unroll
            for (int ww = 0; ww < 8; ++ww) { CARW[ww * 64 + lane] = H; const float a = WAG[(ww * 64 + lane) * 2], h = WAG[(ww * 64 + lane) * 2 + 1]; H = a * H + h; } }
        __syncthreads();
        GAS bf16* gp = Z + zr * LDZ + ZC_GA + cb0;
#pragma unroll
        for (int q = 0; q < 8; ++q) { const f32x4 cr = *(const LAS f32x4*)(CARW + w * 64 + 8 * q + 4 * hi);
            const v2u gw = *(const GAS v2u*)(gp + 8 * q);
            const float h0 = (uv[q][0] + av[q][0] * cr[0]) * pg8::bf_lo(gw.x), h1 = (uv[q][1] + av[q][1] * cr[1]) * pg8::bf_hi(gw.x);
            const float h2 = (uv[q][2] + av[q][2] * cr[2]) * pg8::bf_lo(gw.y), h3 = (uv[q][3] + av[q][3] * cr[3]) * pg8::bf_hi(gw.y);
            v2u o; o.x = pg8::cvt_pk_bf16(h0, h1); o.y = pg8::cvt_pk_bf16(h2, h3); *(GAS v2u*)(gp + 8 * q) = o; }
        __syncthreads();
    }
}

__device__ __forceinline__ void cumsum_unit(float* CBh, LAS unsigned char* lds) {
    int tid_ = threadIdx.x; asm volatile("" : "+v"(tid_));
    const int tid = tid_, lane = tid & 63, w = tid >> 6;
    LAS float* wsum = (LAS float*)(lds + RING_OFF + 16384);
    f32x4 v[4]; float s = 0.f;
#pragma unroll
    for (int j = 0; j < 4; ++j) { v[j] = *(const f32x4*)(CBh + tid * 16 + 4 * j);
#pragma unroll
        for (int e = 0; e < 4; ++e) { s += v[j][e]; v[j][e] = s; } }
    float inc = s;
#pragma unroll
    for (int d = 1; d < 64; d <<= 1) { const float o = __shfl_up(inc, d, 64); if (lane >= d) inc += o; }
    if (lane == 63) wsum[w] = inc;
    __syncthreads();
    float off = inc - s;
    for (int ww = 0; ww < w; ++ww) off += wsum[ww];
#pragma unroll
    for (int j = 0; j < 4; ++j) { f32x4 o;
#pragma unroll
        for (int e = 0; e < 4; ++e) o[e] = -(off + v[j][e]) * LOG2E;
        *(f32x4*)(CBh + tid * 16 + 4 * j) = o; }
    __syncthreads();
}

struct SchedIn { pg8::TileOrder o; const bf16* XNc; const bf16* WinT; bf16* Z;
    __device__ __forceinline__ bool next(int i, pg8::Unit& u) const { int pm, pn; if (!o.map(i, pm, pn)) return false; u.pm = pm; u.pn = pn; u.z = 0; u.ldo = LDZ;
        u.A = XNc + (size_t)pm * 256 * D; u.B = WinT + (size_t)pn * 256 * D; u.O = Z + (size_t)pm * 256 * LDZ + (pn < NZT ? pn : 0) * 256; u.G = nullptr; return true; } };
struct SchedMemKV { int q; const bf16 *MN, *WkT, *WvT; bf16 *MK, *MVT;
    __device__ __forceinline__ bool next(int i, pg8::Unit& u) const { if (i > 0 || q < 0 || q >= 64) return false; u.z = 0; u.G = nullptr;
        if (q < 32) { const int pm = q >> 2, pn = q & 3; u.pm = pm; u.pn = pn; u.A = MN + (size_t)pm * 256 * D; u.B = WkT + (size_t)pn * 256 * D; u.O = MK + (size_t)pm * 256 * D + pn * 256; u.ldo = D; }
        else { const int b = (q - 32) >> 2, pm = (q - 32) & 3; u.pm = pm; u.pn = 0; u.A = WvT + (size_t)pm * 256 * D; u.B = MN + (size_t)b * MEMLEN * D; u.O = MVT + (size_t)b * D * MEMLEN + (size_t)pm * 256 * MEMLEN; u.ldo = MEMLEN; }
        return true; } };
struct SchedMemS { int G, c, chunk; bf16* Z; const bf16* MK;
    __device__ __forceinline__ bool next(int i, pg8::Unit& u) const { const int L = i * G + c; if (L >= 256) return false; const int bl = L >> 7, h = (L >> 5) & 3, pmb = L & 31;
        const size_t r0 = (size_t)bl * T + pmb * 256; u.pm = pmb; u.pn = 0; u.z = 0; u.ldo = LDZ;
        u.A = Z + r0 * LDZ + ZC_MQ + h * 256; u.B = MK + (size_t)((chunk * CHB + bl) * MEMLEN) * D + h * 256; u.O = Z + r0 * LDZ + ZC_MQ + h * 256; u.G = nullptr; return true; } };
struct SchedMemPV { int G, c, chunk; bf16* Z; const bf16* MVT;
    __device__ __forceinline__ bool next(int i, pg8::Unit& u) const { const int L = i * G + c; if (L >= 256) return false; const int bl = L >> 7, h = (L >> 5) & 3, pmb = L & 31;
        const size_t r0 = (size_t)bl * T + pmb * 256; u.pm = pmb; u.pn = 0; u.z = 0; u.ldo = LDZ;
        u.A = Z + r0 * LDZ + ZC_MQ + h * 256; u.B = MVT + (size_t)(chunk * CHB + bl) * D * MEMLEN + (size_t)h * 256 * MEMLEN; u.O = Z + r0 * LDZ + ZC_MQ + h * 256; u.G = Z + r0 * LDZ + ZC_GM + h * 256; return true; } };
struct SchedMerge { pg8::TileOrder o; bf16* Z; const bf16* WBt;
    __device__ __forceinline__ bool next(int i, pg8::Unit& u) const { int pm, pn; if (!o.map(i / 3, pm, pn)) return false; const int nb = i % 3; u.pm = pm; u.pn = pn; u.z = nb; u.ldo = LDZ;
        const int acol = nb == 0 ? ZC_GA : nb == 1 ? ZC_Q : ZC_MQ;
        u.A = Z + (size_t)pm * 256 * LDZ + acol; u.B = WBt + (size_t)nb * D * D + (size_t)pn * 256 * D; u.O = Z + (size_t)pm * 256 * LDZ + ZC_K + pn * 256; u.G = Z + (size_t)pm * 256 * LDZ + ZC_MG + nb * D + pn * 256; return true; } };
struct SchedOut { pg8::TileOrder o; const bf16* Z; const bf16* WoT; bf16* OUTB; int chunk;
    __device__ __forceinline__ bool next(int i, pg8::Unit& u) const { int pm, pn; if (!o.map(i, pm, pn)) return false; u.pm = pm; u.pn = pn; u.z = chunk * MC + pm * 256; u.ldo = D;
        u.A = Z + (size_t)pm * 256 * LDZ + ZC_K; u.B = WoT + (size_t)pn * 256 * D; u.O = OUTB + (size_t)(chunk * MC + pm * 256) * D + pn * 256; u.G = nullptr; return true; } };

__global__ void __launch_bounds__(NWAVES * 64, 2) hybrid_fwd(Args args) {
    extern __shared__ __attribute__((aligned(16))) unsigned char lds_raw[];
    LAS unsigned char* lds = (LAS unsigned char*)lds_raw;
    volatile LAS unsigned* MISC = (volatile LAS unsigned*)(lds + MISC_OFF);
    const int tid = threadIdx.x, lane = tid & 63, wave = __builtin_amdgcn_readfirstlane(tid >> 6);
    const int G = gridDim.x, c = blockIdx.x;
    typedef const __attribute__((address_space(4))) Args* KArgs;
#define KA() ({ KArgs p_ = (KArgs)__builtin_amdgcn_kernarg_segment_ptr(); asm volatile("" : "+s"(p_)); p_; })
    unsigned char* ws = KA()->ws;
    gu32* ctl = (gu32*)(ws + WS_CTL);
    bf16* WinT = (bf16*)(ws + WS_WIN); bf16* WkT = (bf16*)(ws + WS_WK); bf16* WvT = (bf16*)(ws + WS_WV); bf16* WBt = (bf16*)(ws + WS_WB); bf16* WoT = (bf16*)(ws + WS_WO);
    bf16* MN = (bf16*)(ws + WS_MN); bf16* MK = (bf16*)(ws + WS_MK); bf16* MVT = (bf16*)(ws + WS_MVT);
    float* CB = (float*)(ws + WS_CB); float* SSP = (float*)(ws + WS_SSP);
    bf16* XN = (bf16*)(ws + WS_XN); bf16* OUTB = (bf16*)(ws + WS_OUTB); bf16* Z = (bf16*)(ws + WS_Z);
    for (int u = tid; u < (LDS_BYTES - LDSCTL_OFF) / 4; u += NWAVES * 64) ((LAS unsigned*)(lds + LDSCTL_OFF))[u] = 0u;
    __syncthreads();
    (void)xcd_barrier_post((unsigned*)(ctl + CW_BAR), MISC + 8);
#define GRID_BAR() do { XcdBarrier bar_; bar_.bar = (unsigned*)(KA()->ws + WS_CTL) + CW_BAR; bar_.x = xb_xcc_id(); bar_.st = MISC + 8; xcd_barrier(bar_); } while (0)

    {
        KArgs args = KA();
        LAS float* scr = (LAS float*)(lds + RING_OFF + wave * 16384);
        const int gw = c * NWAVES + wave, NGW = G * NWAVES;
        constexpr int I_A = 16 * (5120 / 32), I_B = 16 * (6144 / 32), I_S = 16 * 32;
        constexpr int NITEMS = I_A + I_B + 6 * I_S;
        for (int it = gw; it < NITEMS; it += NGW) {
            int r = it;
            if (r < I_A) { p0_transpose_item(args->w_in, IN_COLS, D, 5120, WinT, scr, r, lane); continue; } r -= I_A;
            if (r < I_B) { p0_transpose_item(args->w_in + 5136, IN_COLS, D, 6144, WinT + (size_t)5120 * D, scr, r, lane); continue; } r -= I_B;
            if (r < I_S) { p0_transpose_item(args->w_mem_k, D, D, D, WkT, scr, r, lane); continue; } r -= I_S;
            if (r < I_S) { p0_transpose_item(args->w_mem_v, D, D, D, WvT, scr, r, lane); continue; } r -= I_S;
            if (r < 3 * I_S) { const int nb = r / I_S; p0_transpose_item(args->w_branch + (size_t)nb * D * D, D, D, D, WBt + (size_t)nb * D * D, scr, r % I_S, lane); continue; } r -= 3 * I_S;
            p0_transpose_item(args->w_out, D, D, D, WoT, scr, r, lane);
        }
        const int gt = c * (NWAVES * 64) + tid, NGT = G * NWAVES * 64;
        for (int e = gt; e < 256 * 128; e += NGT) { const int row = e >> 7, k8 = (e & 127) * 8; v4u o = (v4u){0u, 0u, 0u, 0u};
            if (row < 16) { const float* s = args->w_in + (size_t)k8 * IN_COLS + 5120 + row;
                o.x = pk2(s[0], s[IN_COLS]); o.y = pk2(s[2 * IN_COLS], s[3 * IN_COLS]); o.z = pk2(s[4 * IN_COLS], s[5 * IN_COLS]); o.w = pk2(s[6 * IN_COLS], s[7 * IN_COLS]); }
            *(v4u*)(WinT + (size_t)(LDZ + row) * D + k8) = o; }
        for (int e = gt; e < 16 * 2 * 2 * 4 * 64; e += NGT) { const int ln = e & 63, ks = (e >> 6) & 3, rb = (e >> 8) & 1, mat = (e >> 9) & 1, gg = e >> 10;
            const float* Wm = (mat ? args->w_lru_i : args->w_lru_r) + (size_t)gg * 64 * 64; const int j = 32 * rb + (ln & 31), hh = ln >> 5;
            float f[8];
#pragma unroll
            for (int q = 0; q < 8; ++q) { const int k = 8 * (2 * ks + (q >> 2)) + 4 * hh + (q & 3); f[q] = Wm[k * 64 + j]; }
            v4u o; o.x = pk2(f[0], f[1]); o.y = pk2(f[2], f[3]); o.z = pk2(f[4], f[5]); o.w = pk2(f[6], f[7]);
            *(v4u*)((bf16*)(ws + WS_WRF) + (size_t)e * 8) = o; }
        for (int e = gt; e < D; e += NGT) { const float x = -args->lru_lambda[e]; const float sp = fmaxf(x, 0.f) + log1pf(expf(-fabsf(x))); ((float*)(ws + WS_COEF))[e] = -8.f * sp * LOG2E; }
        for (int m = gw; m < MTOK; m += NGW) rms_row_to_bf16(args->x + (size_t)m * D, args->g_pre, XN + (size_t)m * D, lane);
        for (int m = gw; m < NB * MEMLEN; m += NGW) rms_row_to_bf16(args->mem + (size_t)m * D, args->g_mem, MN + (size_t)m * D, lane);
    }
    cg::this_grid().sync();

    for (int chunk = 0; chunk < NCHUNK; ++chunk) {
        unsigned char* wsl = as_global(KA()->ws);
        int c = blockIdx.x, G = gridDim.x; asm volatile("" : "+s"(c), "+s"(G));
        bf16* WinT = (bf16*)(wsl + WS_WIN); bf16* WkT = (bf16*)(wsl + WS_WK); bf16* WvT = (bf16*)(wsl + WS_WV); bf16* WBt = (bf16*)(wsl + WS_WB); bf16* WoT = (bf16*)(wsl + WS_WO);
        bf16* MN = (bf16*)(wsl + WS_MN); bf16* MK = (bf16*)(wsl + WS_MK); bf16* MVT = (bf16*)(wsl + WS_MVT);
        float* CB = (float*)(wsl + WS_CB); float* SSP = (float*)(wsl + WS_SSP); unsigned* NRM = (unsigned*)(wsl + WS_CTL) + CW_NRM;
        bf16* XN = (bf16*)(wsl + WS_XN); bf16* OUTB = (bf16*)(wsl + WS_OUTB); bf16* Z = (bf16*)(wsl + WS_Z);
        {
            pg8::Gemm g{D, D, D}; SchedIn S; S.o.init(MC / 256, NIN / 256, G, c); S.XNc = XN + (size_t)chunk * MC * D; S.WinT = WinT; S.Z = Z;
            pg8::EpiIn E{as_global(KA()->b_merge), as_global(KA()->b_forget), CB, chunk * MC, NRM};
            pg8::gemm_phase<pg8::EpiIn, SchedIn>(lds + RING_OFF, g, S, E);
            if (chunk == 0) {
                SchedMemKV S2{(c >= 64 && c < 128) ? c - 64 : -1, MN, WkT, WvT, MK, MVT}; pg8::EpiStore E2;
                pg8::gemm_phase<pg8::EpiStore, SchedMemKV>(lds + RING_OFF, g, S2, E2);
            }
        }
        GRID_BAR();
        {
            { KArgs ka = KA(); const LruPtrs lp{as_global(ka->conv_w), as_global(ka->conv_b), as_global(ka->b_lru_r), as_global(ka->b_lru_i), as_global(ka->ws)};
              for (int L = c; L < CHB * 16 * 32; L += G) lru_unit<1>(lp, lds, chunk, L >> 9, (L >> 5) & 15, L & 31); }
            for (int L = c; L < CHB * 16; L += G) cumsum_unit(CB + (size_t)(chunk * CHB * 16 + L) * T, lds);
            pg8::Gemm g{LDZ, D, 256}; SchedMemS S{G, c, chunk, Z, MK}; pg8::EpiSoftmax E{(PG8_LAS float*)(lds + XS_OFF)};
            pg8::gemm_phase<pg8::EpiSoftmax, SchedMemS>(lds + RING_OFF, g, S, E);
        }
        GRID_BAR();
        {
            if (G == 256) {
                const int vcu = (c % 8) * (G / 8) + c / 8, s = vcu & 7, bh = vcu >> 3;
                for (int i = 0; i < 4; ++i) { const int qb = (i == 0) ? s : (i == 1) ? 15 - s : (i == 2) ? 16 + s : 31 - s;
                    attn_body::attn_unit<8>(bh / 16, bh % 16, qb, (const attn_body::bf16*)(Z + ZC_Q), (const attn_body::bf16*)(Z + ZC_K), (const attn_body::bf16*)(Z + ZC_V), (attn_body::bf16*)(Z + ZC_Q),
                                            (const attn_body::bf16*)(Z + ZC_GF), CB + (size_t)(chunk * CHB * 16 + bh) * T, NRM + (chunk * CHB * 16 + bh) * 2, NRM + 1024 + ((chunk * CHB * 16 + bh) * 32 + qb) * 2, (char*)lds_raw + RING_OFF); }
            } else {
                for (int L = c; L < CHB * 16 * 32; L += G) { const int bh = L >> 5, qb = L & 31;
                    attn_body::attn_unit<8>(bh / 16, bh % 16, qb, (const attn_body::bf16*)(Z + ZC_Q), (const attn_body::bf16*)(Z + ZC_K), (const attn_body::bf16*)(Z + ZC_V), (attn_body::bf16*)(Z + ZC_Q),
                                            (const attn_body::bf16*)(Z + ZC_GF), CB + (size_t)(chunk * CHB * 16 + bh) * T, NRM + (chunk * CHB * 16 + bh) * 2, NRM + 1024 + ((chunk * CHB * 16 + bh) * 32 + qb) * 2, (char*)lds_raw + RING_OFF); }
            }
            { KArgs ka = KA(); const LruPtrs lp{as_global(ka->conv_w), as_global(ka->conv_b), as_global(ka->b_lru_r), as_global(ka->b_lru_i), as_global(ka->ws)};
              for (int L = c; L < CHB * 16 * 32; L += G) lru_unit<3>(lp, lds, chunk, L >> 9, (L >> 5) & 15, L & 31); }
            pg8::Gemm g{LDZ, MEMLEN, 256}; SchedMemPV S{G, c, chunk, Z, MVT}; pg8::EpiMul E;
            pg8::gemm_phase<pg8::EpiMul, SchedMemPV>(lds + RING_OFF, g, S, E);
        }
        GRID_BAR();
        {
            pg8::Gemm g{LDZ, D, D}; SchedMerge S; S.o.init(MC / 256, D / 256, G, c); S.Z = Z; S.WBt = WBt; pg8::EpiMerge E;
            pg8::gemm_phase<pg8::EpiMerge, SchedMerge>(lds + RING_OFF, g, S, E);
        }
        GRID_BAR();
        {
            pg8::Gemm g{LDZ, D, D}; SchedOut S; S.o.init(MC / 256, D / 256, G, c); S.Z = Z; S.WoT = WoT; S.OUTB = OUTB; S.chunk = chunk; pg8::EpiOut E{SSP};
            pg8::gemm_phase<pg8::EpiOut, SchedOut>(lds + RING_OFF, g, S, E);
        }
        GRID_BAR();
    }
    {
        KArgs args = KA();
        const float* SSP = (const float*)(as_global(args->ws) + WS_SSP); const bf16* OUTB = (const bf16*)(as_global(args->ws) + WS_OUTB);
        const float* xg_ = as_global(args->x); const float* gpost_ = as_global(args->g_post); float* outg_ = as_global(args->out);
        int tid_ = threadIdx.x; asm volatile("" : "+v"(tid_)); const int lane = tid_ & 63, wave = __builtin_amdgcn_readfirstlane(tid_ >> 6);
        const int gw = c * NWAVES + wave, NGW = G * NWAVES;
        for (int m = gw; m < MTOK; m += NGW) {
            float sp = (lane < 16) ? SSP[(size_t)m * 16 + lane] : 0.f; sp = wave_sum(sp);
            const float rs = 1.f / sqrtf(sp * (1.f / D) + RMS_EPS);
            const f32x4* xr = (const f32x4*)(xg_ + (size_t)m * D) + lane; const f32x4* gr = (const f32x4*)gpost_ + lane;
            const v2u* orow = (const v2u*)(OUTB + (size_t)m * D) + lane; f32x4* yr = (f32x4*)(outg_ + (size_t)m * D) + lane;
#pragma unroll
            for (int j = 0; j < 4; ++j) { const f32x4 xv = xr[64 * j], gg = gr[64 * j]; const v2u ow = orow[64 * j]; f32x4 y;
                y.x = xv.x + pg8::bf_lo(ow.x) * rs * gg.x; y.y = xv.y + pg8::bf_hi(ow.x) * rs * gg.y; y.z = xv.z + pg8::bf_lo(ow.y) * rs * gg.z; y.w = xv.w + pg8::bf_hi(ow.y) * rs * gg.w;
                yr[64 * j] = y; }
        }
    }
#undef GRID_BAR
#undef KA
}

extern "C" void kernel_launch(void* const* d_in, const int* in_sizes, int n_in, void* d_out, int out_size, void* d_ws, size_t ws_size, hipStream_t stream) {
    static int grid = 0;
    if (grid == 0) {
        if (n_in != 19 || in_sizes[0] != MTOK * D || out_size != MTOK * D || ws_size < WS_END) { fprintf(stderr, "kernel_launch: unexpected shapes (n_in %d, in0 %d, out %d, ws %zu); nothing launched\n", n_in, n_in > 0 ? in_sizes[0] : -1, out_size, ws_size); grid = -1; return; }
        int dev = 0, cus = 0, per_cu = 0;
        if (hipGetDevice(&dev) != hipSuccess || hipDeviceGetAttribute(&cus, hipDeviceAttributeMultiprocessorCount, dev) != hipSuccess) { grid = -1; return; }
        if (hipFuncSetAttribute((const void*)hybrid_fwd, hipFuncAttributeMaxDynamicSharedMemorySize, LDS_BYTES) != hipSuccess) { fprintf(stderr, "kernel_launch: hipFuncSetAttribute failed\n"); grid = -1; return; }
        if (hipOccupancyMaxActiveBlocksPerMultiprocessor(&per_cu, (const void*)hybrid_fwd, NWAVES * 64, LDS_BYTES) != hipSuccess || per_cu < 1) { fprintf(stderr, "kernel_launch: occupancy query reports %d\n", per_cu); per_cu = 1; }
        (void)hipGetLastError();
        grid = cus;
    }
    if (grid < 0) return;
    if (hipMemsetAsync((char*)d_ws + WS_CTL, 0, CTL_ZERO_BYTES, stream) != hipSuccess) { fprintf(stderr, "kernel_launch: hipMemsetAsync failed\n"); return; }
    Args a{};
    a.x = (const float*)d_in[0]; a.mem = (const float*)d_in[1]; a.g_pre = (const float*)d_in[2]; a.w_in = (const float*)d_in[3]; a.conv_w = (const float*)d_in[4]; a.conv_b = (const float*)d_in[5];
    a.w_lru_r = (const float*)d_in[6]; a.b_lru_r = (const float*)d_in[7]; a.w_lru_i = (const float*)d_in[8]; a.b_lru_i = (const float*)d_in[9]; a.lru_lambda = (const float*)d_in[10]; a.b_forget = (const float*)d_in[11];
    a.g_mem = (const float*)d_in[12]; a.w_mem_k = (const float*)d_in[13]; a.w_mem_v = (const float*)d_in[14]; a.w_branch = (const float*)d_in[15]; a.b_merge = (const float*)d_in[16]; a.w_out = (const float*)d_in[17]; a.g_post = (const float*)d_in[18];
    a.out = (float*)d_out; a.ws = (unsigned char*)d_ws;
    void* kargs[] = {&a};
    const hipError_t le = hipLaunchCooperativeKernel((const void*)hybrid_fwd, dim3(grid), dim3(NWAVES * 64), kargs, LDS_BYTES, stream);
    if (le != hipSuccess) fprintf(stderr, "kernel_launch: cooperative launch failed: %s (grid %d)\n", hipGetErrorName(le), grid);
}
```

```cpp
#include <hip/hip_runtime.h>
#include <hip/hip_cooperative_groups.h>
#include <hip/hip_bf16.h>
#include <cstdio>
#include <cstdint>
#include <cmath>
namespace cg = cooperative_groups;

constexpr int NB = 8, T = 8192, D = 1024, MTOK = NB * T;
constexpr int CHB = 2, MC = CHB * T, NCHUNK = NB / CHB;
constexpr int IN_COLS = 11280;
constexpr int LDZ = 1024, NZC = 11264, NZT = 44, NIN = 11520;
constexpr size_t ZBLK = (size_t)MC * 1024;
constexpr size_t ZC_AX = 0 * ZBLK, ZC_GA = 1 * ZBLK, ZC_Q = 2 * ZBLK, ZC_K = 3 * ZBLK, ZC_V = 4 * ZBLK, ZC_GF = 5 * ZBLK, ZC_MQ = 6 * ZBLK, ZC_GM = 7 * ZBLK, ZC_MG = 8 * ZBLK;
constexpr int MEMLEN = 256;
constexpr float RMS_EPS = 1e-6f;
constexpr float LOG2E = 1.4426950408889634f;

namespace pg8 {
#define PG8_LAS __attribute__((address_space(3)))
typedef unsigned short bf16_t;
typedef short bf16x8 __attribute__((ext_vector_type(8)));
typedef float f32x4 __attribute__((ext_vector_type(4)));
typedef unsigned u32x4 __attribute__((ext_vector_type(4)));
constexpr int BM = 256, BK = 64, HALF = 128, HTB = HALF * BK * 2, STAGE_BYTES = 8 * HTB, NXCD = 8, WGM = 8;

__host__ __device__ __forceinline__ int lds_byte(int r, int c) { const int st = (r >> 4) * 2 + (c >> 5), rr = r & 15, cc = c & 31, ob = rr * 64 + cc * 2; return st * 1024 + (ob ^ (((ob >> 9) & 1) << 5)); }
__host__ __device__ __forceinline__ void stage_rc(int b, int& R, int& C) { const int st = b / 1024, sb = b % 1024, swz = sb ^ (((sb >> 9) & 1) << 5); R = (st >> 1) * 16 + swz / 64; C = (st & 1) * 32 + (swz % 64) / 2; }
__host__ __device__ __forceinline__ int perm32(int rho) { const int n = rho >> 4, i = rho & 15; return 8 * (i >> 2) + 4 * n + (i & 3); }

struct Unit { int pm, pn, z, ldo; const bf16_t* A; const bf16_t* B; bf16_t* O; const bf16_t* G; };
struct Gemm { int lda, ldb, K; };

struct TileOrder {
    int nM, nN, nwg, G, c;
    __device__ __forceinline__ void init(int nM_, int nN_, int G_, int c_) { nM = nM_; nN = nN_; nwg = nM * nN; G = G_; c = c_; }
    __device__ __forceinline__ bool map(int i, int& pm, int& pn) const {
        const long L = (long)i * G + c; if (L >= nwg) return false;
        int wgid = (int)L; { const int q = nwg / NXCD, r = nwg % NXCD, xcd = wgid % NXCD, off = wgid / NXCD; wgid = (xcd < r ? xcd * (q + 1) : r * (q + 1) + (xcd - r) * q) + off; }
        const int nig = WGM * nN, gid = wgid / nig, fm = gid * WGM, gsz = (nM - fm) < WGM ? (nM - fm) : WGM;
        pm = fm + ((wgid % nig) % gsz); pn = (wgid % nig) / gsz; return true;
    }
};

__device__ __forceinline__ unsigned cvt_pk_bf16(float lo, float hi) { unsigned r; asm volatile("v_cvt_pk_bf16_f32 %0, %1, %2" : "=v"(r) : "v"(lo), "v"(hi)); return r; }
__device__ __forceinline__ float bf_lo(unsigned w) { return __builtin_bit_cast(float, w << 16); }
__device__ __forceinline__ float bf_hi(unsigned w) { return __builtin_bit_cast(float, w & 0xffff0000u); }
__device__ __forceinline__ float sigm(float x) { return __builtin_amdgcn_rcpf(1.f + __expf(-x)); }

template <class Epi, class Sched>
__device__ __forceinline__ void gemm_phase(PG8_LAS unsigned char* lds, const Gemm g, const Sched& S, const Epi& E) {
    int tid_ = threadIdx.x; asm volatile("" : "+v"(tid_));
    const int tid = tid_, wid = __builtin_amdgcn_readfirstlane(tid >> 6), lane = tid & 63, wr = wid >> 2, wc = wid & 3, fr = lane & 15, fq = lane >> 4;
    const int K = g.K, nt = K / BK;
    unsigned voffA[2], voffB[2];
#pragma unroll
    for (int i = 0; i < 2; ++i) { int R, C; stage_rc(tid * 16 + i * 8192, R, C); const int Rb = (R & ~31) + perm32(R & 31);
        voffA[i] = (unsigned)(R * g.lda + C) * 2u; voffB[i] = (unsigned)(Rb * g.ldb + C) * 2u; }
    const size_t kstep = (size_t)(BK * 2);
    const size_t hstepA = (size_t)HALF * g.lda * 2, hstepB = (size_t)HALF * g.ldb * 2;
    const unsigned ldsw = (unsigned)wid * 1024u;
    const int aoff = lds_byte(wr * 64 + fr, fq * 8), boff = lds_byte(wc * 32 + fr, fq * 8);
#define PG8_SA(b, h) (((b) * 2 + (h)) * HTB)
#define PG8_SB(b, h) ((4 + (b) * 2 + (h)) * HTB)
#define PG8_STAGE(bufoff, gbase, voff) do { _Pragma("unroll") for (int _i = 0; _i < 2; ++_i) \
        __builtin_amdgcn_global_load_lds((const unsigned*)((const char*)(gbase) + (voff)[_i]), (PG8_LAS unsigned*)(lds + (bufoff) + ldsw + _i * 8192), 16, 0, 0); } while (0)
#define PG8_LDA(dst, b, h) do { _Pragma("unroll") for (int m = 0; m < 4; ++m) _Pragma("unroll") for (int k = 0; k < 2; ++k) dst[m][k] = *(const PG8_LAS bf16x8*)(lds + PG8_SA(b, h) + aoff + m * 2048 + k * 1024); } while (0)
#define PG8_LDB(dst, b, h) do { _Pragma("unroll") for (int n = 0; n < 2; ++n) _Pragma("unroll") for (int k = 0; k < 2; ++k) dst[n][k] = *(const PG8_LAS bf16x8*)(lds + PG8_SB(b, h) + boff + n * 2048 + k * 1024); } while (0)
#define PG8_MMA(ai, bj, At, Bt) do { __builtin_amdgcn_s_setprio(1); _Pragma("unroll") for (int m = 0; m < 4; ++m) _Pragma("unroll") for (int n = 0; n < 2; ++n) _Pragma("unroll") for (int k = 0; k < 2; ++k) \
        acc[ai][bj][m][n] = __builtin_amdgcn_mfma_f32_16x16x32_bf16(Bt[n][k], At[m][k], acc[ai][bj][m][n], 0, 0, 0); __builtin_amdgcn_s_setprio(0); } while (0)
#define PG8_WAIT_V(n) asm volatile("s_waitcnt vmcnt(" #n ")" ::: "memory")
#define PG8_WAIT_L(n) asm volatile("s_waitcnt lgkmcnt(" #n ")" ::: "memory")
#define PG8_BAR __builtin_amdgcn_s_barrier()
#define PG8_SCHED __builtin_amdgcn_sched_barrier(0)
    Unit cur, nxt; int ui = 0;
    if (!S.next(0, cur)) return;
    f32x4 acc[2][2][4][2];
#pragma unroll
    for (int a = 0; a < 2; ++a)
#pragma unroll
        for (int b = 0; b < 2; ++b)
#pragma unroll
            for (int m = 0; m < 4; ++m)
#pragma unroll
                for (int n = 0; n < 2; ++n) acc[a][b][m][n] = (f32x4){0.f, 0.f, 0.f, 0.f};
    bf16x8 At[4][2], B0[2][2], B1[2][2];
    const char* cA = (const char*)cur.A; const char* cB = (const char*)cur.B;
    PG8_STAGE(PG8_SB(0, 0), cB, voffB); PG8_STAGE(PG8_SB(0, 1), cB + hstepB, voffB); PG8_STAGE(PG8_SA(0, 0), cA, voffA); PG8_STAGE(PG8_SA(0, 1), cA + hstepA, voffA);
    if (wr == 1) PG8_BAR;
    PG8_WAIT_V(2); PG8_BAR;
    PG8_STAGE(PG8_SB(1, 0), cB + kstep, voffB); PG8_STAGE(PG8_SA(1, 0), cA + kstep, voffA); PG8_STAGE(PG8_SB(1, 1), cB + hstepB + kstep, voffB);
    PG8_WAIT_V(6); PG8_BAR;
    for (;;) {
        const bool has_next = S.next(ui + 1, nxt);
        const char* nA = has_next ? (const char*)nxt.A : cA; const char* nB = has_next ? (const char*)nxt.B : cB;
        for (int t = 0; t < nt; t += 2) {
            const bool last = (t == nt - 2);
            const char* a1 = cA + (size_t)(t + 1) * kstep;
            const char* a2 = last ? nA : cA + (size_t)(t + 2) * kstep; const char* b2 = last ? nB : cB + (size_t)(t + 2) * kstep;
            const char* a3 = a2 + kstep; const char* b3 = b2 + kstep;
            PG8_LDB(B0, 0, 0); PG8_LDB(B1, 0, 1); PG8_SCHED; PG8_LDA(At, 0, 0); PG8_STAGE(PG8_SA(1, 1), a1 + hstepA, voffA);
            PG8_WAIT_V(8); PG8_WAIT_L(0); PG8_BAR; PG8_MMA(0, 0, At, B0); PG8_MMA(0, 1, At, B1); PG8_BAR; PG8_SCHED;
            PG8_LDA(At, 0, 1); PG8_STAGE(PG8_SB(0, 0), b2, voffB); PG8_STAGE(PG8_SB(0, 1), b2 + hstepB, voffB); PG8_STAGE(PG8_SA(0, 0), a2, voffA);
            PG8_WAIT_V(8); PG8_WAIT_L(0); PG8_BAR; PG8_MMA(1, 0, At, B0); PG8_MMA(1, 1, At, B1); PG8_BAR; PG8_SCHED;
            PG8_LDB(B0, 1, 0); PG8_LDB(B1, 1, 1); PG8_SCHED; PG8_LDA(At, 1, 0); PG8_STAGE(PG8_SA(0, 1), a2 + hstepA, voffA);
            PG8_WAIT_V(8); PG8_WAIT_L(0); PG8_BAR; PG8_MMA(0, 0, At, B0); PG8_MMA(0, 1, At, B1); PG8_BAR; PG8_SCHED;
            PG8_LDA(At, 1, 1); PG8_STAGE(PG8_SB(1, 0), b3, voffB); PG8_STAGE(PG8_SB(1, 1), b3 + hstepB, voffB); PG8_STAGE(PG8_SA(1, 0), a3, voffA);
            PG8_WAIT_V(8); PG8_WAIT_L(0); PG8_BAR; PG8_MMA(1, 0, At, B0); PG8_MMA(1, 1, At, B1); PG8_BAR; PG8_SCHED;
        }
        if (wr == 0) PG8_BAR;
        E(acc, cur, wr, wc, fr, fq);
        if (!has_next) break;
        if (!(Epi::KEEP && cur.z < 2)) {
#pragma unroll
        for (int a = 0; a < 2; ++a)
#pragma unroll
            for (int b = 0; b < 2; ++b)
#pragma unroll
                for (int m = 0; m < 4; ++m)
#pragma unroll
                    for (int n = 0; n < 2; ++n) acc[a][b][m][n] = (f32x4){0.f, 0.f, 0.f, 0.f};
        }
        cur = nxt; cA = nA; cB = nB; ++ui;
        if (wr == 1) PG8_BAR;
    }
    PG8_WAIT_V(0);
    PG8_BAR;
#undef PG8_SA
#undef PG8_SB
#undef PG8_STAGE
#undef PG8_LDA
#undef PG8_LDB
#undef PG8_MMA
#undef PG8_WAIT_V
#undef PG8_WAIT_L
#undef PG8_SCHED
}

__device__ __forceinline__ float shx(float v, int lane, int m) { return __builtin_bit_cast(float, __builtin_amdgcn_ds_bpermute((lane ^ m) << 2, __builtin_bit_cast(int, v))); }
__device__ __forceinline__ u32x4 pack8(const f32x4 v0, const f32x4 v1) { u32x4 w; w.x = cvt_pk_bf16(v0[0], v0[1]); w.y = cvt_pk_bf16(v0[2], v0[3]); w.z = cvt_pk_bf16(v1[0], v1[1]); w.w = cvt_pk_bf16(v1[2], v1[3]); return w; }
__device__ __forceinline__ void unpack8(const u32x4 w, f32x4& v0, f32x4& v1) { v0[0] = bf_lo(w.x); v0[1] = bf_hi(w.x); v0[2] = bf_lo(w.y); v0[3] = bf_hi(w.y); v1[0] = bf_lo(w.z); v1[1] = bf_hi(w.z); v1[2] = bf_lo(w.w); v1[3] = bf_hi(w.w); }

struct EpiIn {
    static constexpr bool KEEP = false;
    const float* b_merge; int tok0;
    unsigned* NRM;
    __device__ __forceinline__ void operator()(f32x4 (&acc)[2][2][4][2], const Unit& u, int wr, int wc, int fr, int fq) const {
        asm volatile("" : "+v"(fr), "+v"(fq));
        const int lane_ = fq * 16 + fr; (void)lane_;
        const int pn = u.pn;
        {
            const int kind = ((pn >= 4 && pn < 8) || (pn >= 20 && pn < 24) || (pn >= 28 && pn < 32)) ? 1 : (pn >= 8 && pn < 12) ? 2 : (pn >= 32) ? 3 : 0;
            bf16_t* base = u.O + (size_t)(wr * 64 + fr) * LDZ + wc * 32 + 8 * fq;
            f32x4 bv[2][2];
#pragma unroll
            for (int bj = 0; bj < 2; ++bj)
#pragma unroll
                for (int n = 0; n < 2; ++n) bv[bj][n] = (kind == 3) ? *(const f32x4*)(b_merge + (pn * 256 - 8192) + wc * 32 + 8 * fq + bj * HALF + 4 * n) : (f32x4){0.f, 0.f, 0.f, 0.f};
#pragma unroll
            for (int ai = 0; ai < 2; ++ai)
#pragma unroll
                for (int m = 0; m < 4; ++m) { bf16_t* rowp = base + (size_t)(ai * HALF + m * 16) * LDZ;
#pragma unroll
                    for (int bj = 0; bj < 2; ++bj) { f32x4 v0 = acc[ai][bj][m][0], v1 = acc[ai][bj][m][1];
                        if (kind == 1) {
#pragma unroll
                            for (int e = 0; e < 4; ++e) { v0[e] = v0[e] * sigm(v0[e]); v1[e] = v1[e] * sigm(v1[e]); } }
                        else if (kind == 2) { v0 = v0 * (0.125f * LOG2E); v1 = v1 * (0.125f * LOG2E); }
                        else if (kind == 3) {
#pragma unroll
                            for (int e = 0; e < 4; ++e) { v0[e] = sigm(v0[e] + bv[bj][0][e]); v1[e] = sigm(v1[e] + bv[bj][1][e]); } }
                        __builtin_nontemporal_store(pack8(v0, v1), (u32x4*)(rowp + bj * HALF)); } }
            if (pn >= 12 && pn < 16) {
                const float sc2 = (pn < 12) ? (0.125f * LOG2E) * (0.125f * LOG2E) : 1.f;
                const int tokb = tok0 + u.pm * BM, bg = tokb >> 13, qb = (tokb & (T - 1)) >> 8;
#pragma unroll
                for (int bj = 0; bj < 2; ++bj) { float mx = 0.f;
#pragma unroll
                    for (int ai = 0; ai < 2; ++ai)
#pragma unroll
                        for (int m = 0; m < 4; ++m) { const f32x4 v0 = acc[ai][bj][m][0], v1 = acc[ai][bj][m][1];
                            float q = (v0[0] * v0[0] + v0[1] * v0[1]) + (v0[2] * v0[2] + v0[3] * v0[3]) + (v1[0] * v1[0] + v1[1] * v1[1]) + (v1[2] * v1[2] + v1[3] * v1[3]);
                            q += shx(q, lane_, 16); q += shx(q, lane_, 32); mx = fmaxf(mx, q); }
                    mx = fmaxf(mx, shx(mx, lane_, 1)); mx = fmaxf(mx, shx(mx, lane_, 2)); mx = fmaxf(mx, shx(mx, lane_, 4)); mx = fmaxf(mx, shx(mx, lane_, 8));
                    if (lane_ == 0) { const int head = (pn & 3) * 4 + 2 * bj + (wc >> 1), half = wc & 1;
                        unsigned* w = (pn < 12) ? NRM + 1024 + ((bg * 16 + head) * 32 + qb) * 2 + half : NRM + (bg * 16 + head) * 2 + half;
                        __hip_atomic_fetch_max(w, __builtin_bit_cast(unsigned, mx * sc2 * 1.02f), __ATOMIC_RELAXED, __HIP_MEMORY_SCOPE_AGENT); } }
            }
        }
    }
};
struct EpiStore {
    static constexpr bool KEEP = false;
    __device__ __forceinline__ void operator()(f32x4 (&acc)[2][2][4][2], const Unit& u, int wr, int wc, int fr, int fq) const {
        asm volatile("" : "+v"(fr), "+v"(fq));
        const int lane_ = fq * 16 + fr; (void)lane_;
        bf16_t* base = u.O + (size_t)(wr * 64 + fr) * u.ldo + wc * 32 + 8 * fq;
#pragma unroll
        for (int ai = 0; ai < 2; ++ai)
#pragma unroll
            for (int m = 0; m < 4; ++m) { bf16_t* rowp = base + (size_t)(ai * HALF + m * 16) * u.ldo;
#pragma unroll
                for (int bj = 0; bj < 2; ++bj) *(u32x4*)(rowp + bj * HALF) = pack8(acc[ai][bj][m][0], acc[ai][bj][m][1]); }
    }
};
struct EpiSoftmax {
    static constexpr bool KEEP = false;
    PG8_LAS float* xs;
    __device__ __forceinline__ void operator()(f32x4 (&acc)[2][2][4][2], const Unit& u, int wr, int wc, int fr, int fq) const {
        asm volatile("" : "+v"(fr), "+v"(fq));
        const int lane_ = fq * 16 + fr; (void)lane_;
        const float sc = 0.0625f * LOG2E;
        float lm[2][4];
#pragma unroll
        for (int ai = 0; ai < 2; ++ai)
#pragma unroll
            for (int m = 0; m < 4; ++m) {
                float mx = -INFINITY;
#pragma unroll
                for (int bj = 0; bj < 2; ++bj)
#pragma unroll
                    for (int n = 0; n < 2; ++n)
#pragma unroll
                        for (int e = 0; e < 4; ++e) mx = fmaxf(mx, acc[ai][bj][m][n][e]);
                mx = fmaxf(mx, shx(mx, lane_, 16)); mx = fmaxf(mx, shx(mx, lane_, 32)); mx *= sc;
                float s = 0.f;
#pragma unroll
                for (int bj = 0; bj < 2; ++bj)
#pragma unroll
                    for (int n = 0; n < 2; ++n)
#pragma unroll
                        for (int e = 0; e < 4; ++e) { const float p = __builtin_amdgcn_exp2f(acc[ai][bj][m][n][e] * sc - mx); acc[ai][bj][m][n][e] = p; s += p; }
                s += shx(s, lane_, 16); s += shx(s, lane_, 32);
                lm[ai][m] = mx;
                if (fq == 0) { const int row = ai * HALF + wr * 64 + m * 16 + fr; xs[(row * 4 + wc) * 2] = mx; xs[(row * 4 + wc) * 2 + 1] = s; }
            }
        asm volatile("s_waitcnt lgkmcnt(0)" ::: "memory"); PG8_BAR; asm volatile("" ::: "memory");
        bf16_t* base = u.O + (size_t)(wr * 64 + fr) * u.ldo + wc * 32 + 8 * fq;
#pragma unroll
        for (int ai = 0; ai < 2; ++ai)
#pragma unroll
            for (int m = 0; m < 4; ++m) { const int row = ai * HALF + wr * 64 + m * 16 + fr;
                const f32x4 a = *(const PG8_LAS f32x4*)(xs + row * 8), b = *(const PG8_LAS f32x4*)(xs + row * 8 + 4);
                const float M = fmaxf(fmaxf(a[0], a[2]), fmaxf(b[0], b[2]));
                const float tot = a[1] * __builtin_amdgcn_exp2f(a[0] - M) + a[3] * __builtin_amdgcn_exp2f(a[2] - M) + b[1] * __builtin_amdgcn_exp2f(b[0] - M) + b[3] * __builtin_amdgcn_exp2f(b[2] - M);
                const float f = __builtin_amdgcn_exp2f(lm[ai][m] - M) * __builtin_amdgcn_rcpf(tot);
                bf16_t* rowp = base + (size_t)(ai * HALF + m * 16) * u.ldo;
#pragma unroll
                for (int bj = 0; bj < 2; ++bj) *(u32x4*)(rowp + bj * HALF) = pack8(acc[ai][bj][m][0] * f, acc[ai][bj][m][1] * f); }
    }
};
struct EpiMul {
    static constexpr bool KEEP = false;
    __device__ __forceinline__ void operator()(f32x4 (&acc)[2][2][4][2], const Unit& u, int wr, int wc, int fr, int fq) const {
        asm volatile("" : "+v"(fr), "+v"(fq));
        const size_t lo = (size_t)(wr * 64 + fr) * LDZ + wc * 32 + 8 * fq;
#pragma unroll
        for (int ai = 0; ai < 2; ++ai) {
            u32x4 gw[4][2];
#pragma unroll
            for (int m = 0; m < 4; ++m)
#pragma unroll
                for (int bj = 0; bj < 2; ++bj) gw[m][bj] = *(const u32x4*)(u.G + lo + (size_t)(ai * HALF + m * 16) * LDZ + bj * HALF);
#pragma unroll
            for (int m = 0; m < 4; ++m)
#pragma unroll
                for (int bj = 0; bj < 2; ++bj) { f32x4 g0, g1; unpack8(gw[m][bj], g0, g1);
                    *(u32x4*)(u.O + lo + (size_t)(ai * HALF + m * 16) * LDZ + bj * HALF) = pack8(acc[ai][bj][m][0] * g0, acc[ai][bj][m][1] * g1); }
        }
    }
};
struct EpiMerge {
    static constexpr bool KEEP = true;
    __device__ __forceinline__ void operator()(f32x4 (&acc)[2][2][4][2], const Unit& u, int wr, int wc, int fr, int fq) const {
        asm volatile("" : "+v"(fr), "+v"(fq));
        const size_t lg = (size_t)(wr * 64 + fr) * LDZ + wc * 32 + 8 * fq, lo = (size_t)(wr * 64 + fr) * u.ldo + wc * 32 + 8 * fq;
        const bool last = (u.z == 2);
#pragma unroll
        for (int ai = 0; ai < 2; ++ai) {
            u32x4 gw[4][2], hw[4][2];
#pragma unroll
            for (int m = 0; m < 4; ++m)
#pragma unroll
                for (int bj = 0; bj < 2; ++bj) { const bf16_t* gp = u.G + lg + (size_t)(ai * HALF + m * 16) * LDZ + bj * HALF; gw[m][bj] = *(const u32x4*)gp;
                    hw[m][bj] = (u32x4){0u, 0u, 0u, 0u}; if (!last) hw[m][bj] = *(const u32x4*)(gp + ZBLK); }
#pragma unroll
            for (int m = 0; m < 4; ++m)
#pragma unroll
                for (int bj = 0; bj < 2; ++bj) { f32x4 g0, g1; unpack8(gw[m][bj], g0, g1);
                    if (last) { *(u32x4*)(u.O + lo + (size_t)(ai * HALF + m * 16) * u.ldo + bj * HALF) = pack8(acc[ai][bj][m][0] * g0, acc[ai][bj][m][1] * g1); }
                    else { f32x4 h0, h1; unpack8(hw[m][bj], h0, h1);
#pragma unroll
                        for (int e = 0; e < 4; ++e) { acc[ai][bj][m][0][e] *= g0[e] * __builtin_amdgcn_rcpf(fmaxf(h0[e], 1e-20f)); acc[ai][bj][m][1][e] *= g1[e] * __builtin_amdgcn_rcpf(fmaxf(h1[e], 1e-20f)); } } }
        }
    }
};
struct EpiOut {
    static constexpr bool KEEP = false;
    float* SSP;
    __device__ __forceinline__ void operator()(f32x4 (&acc)[2][2][4][2], const Unit& u, int wr, int wc, int fr, int fq) const {
        asm volatile("" : "+v"(fr), "+v"(fq));
        const int lane_ = fq * 16 + fr; (void)lane_;
        bf16_t* base = u.O + (size_t)(wr * 64 + fr) * u.ldo + wc * 32 + 8 * fq;
#pragma unroll
        for (int ai = 0; ai < 2; ++ai)
#pragma unroll
            for (int m = 0; m < 4; ++m) { bf16_t* rowp = base + (size_t)(ai * HALF + m * 16) * u.ldo; float s = 0.f;
#pragma unroll
                for (int bj = 0; bj < 2; ++bj) { const f32x4 v0 = acc[ai][bj][m][0], v1 = acc[ai][bj][m][1];
                    s += (v0[0] * v0[0] + v0[1] * v0[1]) + (v0[2] * v0[2] + v0[3] * v0[3]) + (v1[0] * v1[0] + v1[1] * v1[1]) + (v1[2] * v1[2] + v1[3] * v1[3]);
                    __builtin_nontemporal_store(pack8(v0, v1), (u32x4*)(rowp + bj * HALF)); }
                s += shx(s, lane_, 16); s += shx(s, lane_, 32);
                if (fq == 0) SSP[(size_t)(u.z + ai * HALF + wr * 64 + m * 16 + fr) * 16 + u.pn * 4 + wc] = s; }
    }
};
#undef PG8_BAR
}

namespace attn_body {
using bf16=__hip_bfloat16;
using bf16x8=__attribute__((ext_vector_type(8)))short;
using s16x4=__attribute__((ext_vector_type(4)))short;
using f32x16=__attribute__((ext_vector_type(16)))float;
using f32x4=__attribute__((ext_vector_type(4)))float;
using u32x4=__attribute__((ext_vector_type(4)))unsigned;
constexpr int BATCH=CHB,NHEAD=16,SEQ=T,D=64,DM=LDZ;
constexpr int NW=8,QBLK=32,QB=QBLK*NW,KVBLK=64,NQB=SEQ/QB;
__device__ __forceinline__ int crow(int r,int hi){return (r&3)+8*(r>>2)+4*hi;}
#define SBAR() __builtin_amdgcn_sched_barrier(0)
__device__ __forceinline__ void cmask(f32x16&p0,f32x16&p1,int jb,int qrel,int hi){
  const float NEG=-INFINITY; int kb=64*jb+4*hi;
  #pragma unroll
  for(int r=0;r<16;++r){int kv=kb+(r&3)+8*(r>>2); if(kv>qrel)p0[r]=NEG; if(kv+32>qrel)p1[r]=NEG;}
}
constexpr int NSLOT=3, SLOTB=8192;
constexpr int LDS_K=0, LDS_V=NSLOT*SLOTB, LDS_WS=2*NSLOT*SLOTB, LDS_OST=LDS_WS+NW*64*4, LDS_BIAS=LDS_OST+NW*4096, LDS_BYTES=LDS_BIAS+SEQ*4;
__device__ __forceinline__ void glds16(const void*gsrc,unsigned lds_dst){unsigned keep;
  asm volatile("s_mov_b32 %0, m0\n\ts_mov_b32 m0, %2\n\ts_nop 0\n\tglobal_load_lds_dwordx4 %1, off\n\ts_mov_b32 m0, %0":"=&s"(keep):"v"(gsrc),"s"(lds_dst):"memory");}
__device__ __forceinline__ float max3f(float a,float b,float c){float r;asm("v_max3_f32 %0, %1, %2, %3":"=v"(r):"v"(a),"v"(b),"v"(c));return r;}
__device__ __forceinline__ float max2f(float a,float b){float r;asm("v_max_f32_e32 %0, %1, %2":"=v"(r):"v"(a),"v"(b));return r;}
__device__ __forceinline__ float fadd_s(float a,float b){float r;asm("v_add_f32_e32 %0, %1, %2":"=v"(r):"v"(a),"v"(b));return r;}
__device__ __forceinline__ float fsub_s(float a,float b){float r;asm("v_sub_f32_e32 %0, %1, %2":"=v"(r):"v"(a),"v"(b));return r;}
typedef float f32x2_t __attribute__((ext_vector_type(2))); typedef __bf16 bf16x2_t __attribute__((ext_vector_type(2)));
__device__ __forceinline__ unsigned cvtpk_s(float lo,float hi){f32x2_t v={lo,hi};bf16x2_t b=__builtin_convertvector(v,bf16x2_t);return __builtin_bit_cast(unsigned,b);}
#define WAIT_BAR(N) asm volatile("s_waitcnt vmcnt(" #N ") lgkmcnt(0)\n\ts_barrier":::"memory")
typedef __attribute__((address_space(3))) const char* lds_cptr;
typedef short v4i16_t __attribute__((ext_vector_type(4)));
__device__ __forceinline__ void cinit(f32x16&c0,f32x16&c1,lds_cptr bp,int hi,float negmh){
  #pragma unroll
  for(int g=0;g<4;++g){
    const f32x4 b0=*(const __attribute__((address_space(3))) f32x4*)(bp+(8*g+4*hi)*4);
    const f32x4 b1=*(const __attribute__((address_space(3))) f32x4*)(bp+(32+8*g+4*hi)*4);
    #pragma unroll
    for(int e=0;e<4;++e){c0[4*g+e]=b0[e]+negmh;c1[4*g+e]=b1[e]+negmh;}}
}
__device__ __forceinline__ void qkt(f32x16&p0,f32x16&p1,const char*Kslot,const bf16x8*qr,int r32,int hi){
  const char*kb=Kslot+hi*1024+r32*16;
  #pragma unroll
  for(int d0=0;d0<4;++d0){
    const bf16x8 b0=*reinterpret_cast<const bf16x8*>(kb+d0*2048);
    const bf16x8 b1=*reinterpret_cast<const bf16x8*>(kb+d0*2048+512);
    p0=__builtin_amdgcn_mfma_f32_32x32x16_bf16(b0,qr[d0],p0,0,0,0);p1=__builtin_amdgcn_mfma_f32_32x32x16_bf16(b1,qr[d0],p1,0,0,0);}
}
__device__ __forceinline__ void kload8(bf16x8*kf,lds_cptr kp){
  kf[0]=*(const __attribute__((address_space(3))) bf16x8*)(kp);      kf[1]=*(const __attribute__((address_space(3))) bf16x8*)(kp+512);
  kf[2]=*(const __attribute__((address_space(3))) bf16x8*)(kp+2048); kf[3]=*(const __attribute__((address_space(3))) bf16x8*)(kp+2560);
  kf[4]=*(const __attribute__((address_space(3))) bf16x8*)(kp+4096); kf[5]=*(const __attribute__((address_space(3))) bf16x8*)(kp+4608);
  kf[6]=*(const __attribute__((address_space(3))) bf16x8*)(kp+6144); kf[7]=*(const __attribute__((address_space(3))) bf16x8*)(kp+6656);
}
__device__ __forceinline__ void kload2(bf16x8*kf,lds_cptr kp,int j){ kf[2*j]=*(const __attribute__((address_space(3))) bf16x8*)(kp+j*2048); kf[2*j+1]=*(const __attribute__((address_space(3))) bf16x8*)(kp+j*2048+512); }
__device__ __forceinline__ s16x4 vtr(lds_cptr p){ return __builtin_bit_cast(s16x4,__builtin_amdgcn_ds_read_tr16_b64_v4i16((__attribute__((address_space(3))) v4i16_t*)p)); }
__device__ __forceinline__ float rowmax(const f32x16&p0,const f32x16&p1){
  float a=max3f(p0[0],p0[1],p1[0]),b=max3f(p0[2],p0[3],p1[1]);a=max3f(a,p1[2],p1[3]);
  #pragma unroll
  for(int r=4;r<16;r+=4){a=max3f(a,p0[r],p0[r+1]);b=max3f(b,p0[r+2],p0[r+3]);a=max3f(a,p1[r],p1[r+1]);b=max3f(b,p1[r+2],p1[r+3]);}
  const float m=max2f(a,b);
  auto rr=__builtin_amdgcn_permlane32_swap(__float_as_uint(m),__float_as_uint(m),false,false);
  return max2f(__uint_as_float(rr[0]),__uint_as_float(rr[1]));
}
__device__ __forceinline__ void pv(f32x16*o,int vb,bf16x8 pa0,bf16x8 pa1,bf16x8 pa2,bf16x8 pa3){
  #pragma unroll
  for(int d0=0;d0<2;++d0){s16x4 lo[4],hi[4];
    #pragma unroll
    for(int ks=0;ks<4;++ks){
      asm volatile("ds_read_b64_tr_b16 %0,%1 offset:%c2":"=&v"(lo[ks]):"v"(vb),"i"(d0*4096+ks*1024):"memory");
      asm volatile("ds_read_b64_tr_b16 %0,%1 offset:%c2":"=&v"(hi[ks]):"v"(vb),"i"(d0*4096+ks*1024+512):"memory");}
    asm volatile("s_waitcnt lgkmcnt(0)":::"memory");SBAR();
    #define PK(k) (bf16x8){lo[k][0],lo[k][1],lo[k][2],lo[k][3],hi[k][0],hi[k][1],hi[k][2],hi[k][3]}
    o[d0]=__builtin_amdgcn_mfma_f32_32x32x16_bf16(pa0,PK(0),o[d0],0,0,0);
    o[d0]=__builtin_amdgcn_mfma_f32_32x32x16_bf16(pa1,PK(1),o[d0],0,0,0);
    o[d0]=__builtin_amdgcn_mfma_f32_32x32x16_bf16(pa2,PK(2),o[d0],0,0,0);
    o[d0]=__builtin_amdgcn_mfma_f32_32x32x16_bf16(pa3,PK(3),o[d0],0,0,0);
    #undef PK
  }
}
__device__ __forceinline__ u32x4 mul_bf16x8(u32x4 a,u32x4 b){
  u32x4 r;
  r.x=cvtpk_s(pg8::bf_lo(a.x)*pg8::bf_lo(b.x),pg8::bf_hi(a.x)*pg8::bf_hi(b.x)); r.y=cvtpk_s(pg8::bf_lo(a.y)*pg8::bf_lo(b.y),pg8::bf_hi(a.y)*pg8::bf_hi(b.y));
  r.z=cvtpk_s(pg8::bf_lo(a.z)*pg8::bf_lo(b.z),pg8::bf_hi(a.z)*pg8::bf_hi(b.z)); r.w=cvtpk_s(pg8::bf_lo(a.w)*pg8::bf_lo(b.w),pg8::bf_hi(a.w)*pg8::bf_hi(b.w));
  return r;
}

template<int THRL> __device__ __forceinline__ void attn_unit(int b,int h,int qb,const bf16*Q,const bf16*__restrict__ K,const bf16*__restrict__ V,bf16*O,const bf16*GF,const float*CBh,const unsigned*KN,const unsigned*QN,char*shm){
  int tid_=threadIdx.x; asm volatile("":"+v"(tid_));
  const int tid=tid_,lane=tid&63,r32=lane&31,hi=lane>>5; const int wid=__builtin_amdgcn_readfirstlane(tid>>6);
  const long rowbase=(long)b*SEQ; const int q0=qb*QB;
  const bf16*Qw=Q+(rowbase+q0+wid*QBLK)*DM+h*D;
  { const int n4=(q0+QB)>>2; f32x4*dst=(f32x4*)(shm+LDS_BIAS); const f32x4*src=(const f32x4*)CBh;
    for(int i=tid;i<n4;i+=NW*64)dst[i]=src[i]; }
  bf16x8 qr[4];
  #pragma unroll
  for(int d0=0;d0<4;++d0)qr[d0]=*reinterpret_cast<const bf16x8*>(&Qw[(long)r32*DM+d0*16+hi*8]);
  float umin;
  { const bf16*Kd=K+(rowbase+q0+wid*QBLK)*DM+h*D; float ds=0.f,qq=0.f;
    #pragma unroll
    for(int d0=0;d0<4;++d0){ const bf16x8 kk=*reinterpret_cast<const bf16x8*>(&Kd[(long)r32*DM+d0*16+hi*8]);
      #pragma unroll
      for(int e=0;e<8;++e){ const float qf=__builtin_bit_cast(float,(unsigned)(unsigned short)qr[d0][e]<<16); ds+=qf*__builtin_bit_cast(float,(unsigned)(unsigned short)kk[e]<<16); qq+=qf*qf; } }
    { auto rr=__builtin_amdgcn_permlane32_swap(__float_as_uint(ds),__float_as_uint(ds),false,false); ds=__uint_as_float(rr[0])+__uint_as_float(rr[1]); }
    { auto rr=__builtin_amdgcn_permlane32_swap(__float_as_uint(qq),__float_as_uint(qq),false,false); qq=__uint_as_float(rr[0])+__uint_as_float(rr[1]); }
    const float kmx=sqrtf(__uint_as_float(KN[0])+__uint_as_float(KN[1]));
    float v=ds+CBh[q0+wid*QBLK+r32]-sqrtf(qq)*kmx*1.001f;
    #pragma unroll
    for(int m=1;m<32;m<<=1)v=fminf(v,__builtin_bit_cast(float,__builtin_amdgcn_ds_bpermute((lane^m)<<2,__builtin_bit_cast(int,v))));
    float*wmin=(float*)(shm+LDS_WS);
    if(lane==0)wmin[wid*64]=v;
    asm volatile("s_waitcnt lgkmcnt(0)\n\ts_barrier":::"memory");
    umin=wmin[0];
    #pragma unroll
    for(int w_=1;w_<NW;++w_)umin=fminf(umin,wmin[w_*64]); }
  int t0=0;
  { const float cutoff=umin-0.01f-40.f; const int ntm4=(q0+QB)/KVBLK-4; int cnt=0;
    for(int base=0;base<ntm4;base+=64){ const int tt=base+lane; const bool skip=(tt<ntm4)&&(CBh[64*tt+63]<cutoff); cnt+=__popcll(__ballot(skip)); }
    t0=__builtin_amdgcn_readfirstlane(cnt)&~1; }
  const bf16*Kh=K+(rowbase+(long)t0*KVBLK)*DM+h*D,*Vh=V+(rowbase+(long)t0*KVBLK)*DM+h*D;
  const unsigned lds0=(unsigned)(uintptr_t)shm;
  float*wsf=(float*)(shm+LDS_WS)+wid*64;
  asm volatile("s_waitcnt vmcnt(0)":::"memory");
  const bf16*ksrc=Kh+(long)lane*DM+wid*8;
  const bf16*vsrc=Vh+(long)(16*(wid&3)+(lane>>2))*DM+(wid>>2)*32+(lane&3)*8;
  const unsigned kdst=lds0+LDS_K+wid*1024, vdst=lds0+LDS_V+wid*1024;
  #define DMA_K(t,slot) glds16(ksrc+(long)(t)*KVBLK*DM,(unsigned)__builtin_amdgcn_readfirstlane(kdst+(slot)))
  #define DMA_V(t,slot) glds16(vsrc+(long)(t)*KVBLK*DM,(unsigned)__builtin_amdgcn_readfirstlane(vdst+(slot)))
  const int vb0=(int)(lds0+LDS_V)+((lane>>4)&1)*32+(lane&3)*8+(4*hi+((lane&15)>>2))*64;
  const char*Kbase=shm+LDS_K; bf16x8 kf[8];
  const lds_cptr shm3=(lds_cptr)shm; const lds_cptr kp0=shm3+LDS_K+hi*1024+r32*16; const lds_cptr vp0=shm3+LDS_V+((lane>>4)&1)*32+(lane&3)*8+(4*hi+((lane&15)>>2))*64;
  const lds_cptr bias0=shm3+LDS_BIAS+t0*256;
  const int NT=(q0+QB)/KVBLK-t0;
  DMA_K(0,0);DMA_V(0,0);DMA_K(1,SLOTB);
  float mhat=0.f,l_reg=0.f;f32x16 o[2];o[0]=f32x16{};o[1]=f32x16{};
  const int qrel=wid*QBLK+r32;
  #define CMASK(P0,P1,t) do{int jb_=(t)-(NT-4); if(jb_>=0)cmask(P0,P1,jb_,qrel,hi);}while(0)
  bool resc=false;
  #define START(P0,P1) do{ const float rm=rowmax(P0,P1); resc=false; \
    { const float dl=rm; mhat=fadd_s(mhat,dl); \
      _Pragma("unroll") for(int r=0;r<16;++r){P0[r]=fsub_s(P0[r],dl);P1[r]=fsub_s(P1[r],dl);} } \
    _Pragma("unroll") for(int r=0;r<16;++r)P0[r]=__builtin_amdgcn_exp2f(P0[r]); }while(0)
  #define RESC() do{ if(resc){ asm volatile("s_waitcnt lgkmcnt(0)":::"memory"); \
      _Pragma("unroll") for(int d_=0;d_<2;++d_) _Pragma("unroll") for(int r=0;r<16;++r)o[d_][r]*=wsf[crow(r,hi)]; } }while(0)
  f32x16 pA0,pA1,pB0,pB1;
  int sl_prev=0,sl_cur=0,sl_next=SLOTB;
  #define ROT() do{sl_prev=sl_cur;sl_cur=sl_next;sl_next=(sl_next==(NSLOT-1)*SLOTB)?0:sl_next+SLOTB;}while(0)
  DMA_K(2,2*SLOTB);
  WAIT_BAR(3);
  cinit(pA0,pA1,bias0,hi,0.f);
  qkt(pA0,pA1,Kbase,qr,r32,hi);asm volatile("s_nop 15\n\ts_nop 7":"+v"(pA0),"+v"(pA1));CMASK(pA0,pA1,0);
  START(pA0,pA1);
  _Pragma("unroll") for(int r=0;r<16;++r)pA1[r]=__builtin_amdgcn_exp2f(pA1[r]);
  WAIT_BAR(0);
  DMA_K(3,0);DMA_V(1,SLOTB);
  ROT();
  kload8(kf,kp0+sl_cur);
  WAIT_BAR(2);
  s16x4 vlo[8],vhi[8]; u32x4 pw0,pw1,pw2,pw3;
  #define PKW(P,B) cvtpk_s(P[B],P[B+1])
  #define PAF(k) __builtin_bit_cast(bf16x8,pw##k)
  #define VFR(i) (bf16x8){vlo[i][0],vlo[i][1],vlo[i][2],vlo[i][3],vhi[i][0],vhi[i][1],vhi[i][2],vhi[i][3]}
  #define PIN(x) asm volatile("":"+v"(x))
  #define MX3(a,b,c) __builtin_fmaxf(__builtin_fmaxf((a),(b)),(c))
  #define GAPA(MF,A0,A1,A2,A3,W0,W1,PW) do{ MF; sacc+=A0; sacc+=A1; sacc+=A2; sacc+=A3; PIN(sacc); W0; W1; PIN(PW); SBAR(); }while(0)
  #define EX(v) __builtin_amdgcn_exp2f(v)
  #define GAPB(MF,X,B) do{ MF; X[B]=EX(X[B]); X[B+1]=EX(X[B+1]); X[B+2]=EX(X[B+2]); X[B+3]=EX(X[B+3]); PIN(X); SBAR(); }while(0)
  #define VRD(i) do{ vlo[i]=vtr(vp_+(((i)>>2)*4096+((i)&3)*1024)); vhi[i]=vtr(vp_+(((i)>>2)*4096+((i)&3)*1024+512)); }while(0)
  #define KRD(G,j) do{ if(G){ kload2(kf,kp0+sl_next,j); SBAR(); } }while(0)
  #define STEP(C0,C1,P0,P1,t,GK,GV,GL) do{ SBAR(); \
    const lds_cptr vp_=vp0+sl_prev; \
    cinit(C0,C1,bias0+(t)*256,hi,-mhat); SBAR(); \
    VRD(0); SBAR(); float sacc=(P0[0]+P0[1]); \
    GAPA(C0=__builtin_amdgcn_mfma_f32_32x32x16_bf16(kf[0],qr[0],C0,0,0,0), P0[2],P0[3],P0[4],P0[5],     pw0[0]=PKW(P0,0), pw0[1]=PKW(P0,2), pw0); \
    VRD(4); SBAR(); GAPA(C1=__builtin_amdgcn_mfma_f32_32x32x16_bf16(kf[1],qr[0],C1,0,0,0), P0[6],P0[7],P0[8],P0[9],     pw0[2]=PKW(P0,4), pw0[3]=PKW(P0,6), pw0); \
    VRD(1); SBAR(); GAPA(C0=__builtin_amdgcn_mfma_f32_32x32x16_bf16(kf[2],qr[1],C0,0,0,0),   P0[10],P0[11],P0[12],P0[13], pw1[0]=PKW(P0,8), pw1[1]=PKW(P0,10), pw1); \
    VRD(5); SBAR(); GAPA(C1=__builtin_amdgcn_mfma_f32_32x32x16_bf16(kf[3],qr[1],C1,0,0,0),   P0[14],P0[15],P1[0],P1[1],   pw1[2]=PKW(P0,12),pw1[3]=PKW(P0,14), pw1); \
    VRD(2); SBAR(); GAPA(C0=__builtin_amdgcn_mfma_f32_32x32x16_bf16(kf[4],qr[2],C0,0,0,0),   P1[2],P1[3],P1[4],P1[5],     pw2[0]=PKW(P1,0), pw2[1]=PKW(P1,2), pw2); \
    VRD(6); SBAR(); GAPA(C1=__builtin_amdgcn_mfma_f32_32x32x16_bf16(kf[5],qr[2],C1,0,0,0),   P1[6],P1[7],P1[8],P1[9],     pw2[2]=PKW(P1,4), pw2[3]=PKW(P1,6), pw2); \
    VRD(3); SBAR(); GAPA(C0=__builtin_amdgcn_mfma_f32_32x32x16_bf16(kf[6],qr[3],C0,0,0,0),   P1[10],P1[11],P1[12],P1[13], pw3[0]=PKW(P1,8), pw3[1]=PKW(P1,10), pw3); \
    VRD(7); SBAR(); GAPA(C1=__builtin_amdgcn_mfma_f32_32x32x16_bf16(kf[7],qr[3],C1,0,0,0),   P1[14],P1[15],0.f,0.f,       pw3[2]=PKW(P1,12),pw3[3]=PKW(P1,14), pw3); \
    l_reg+=sacc; \
    if(GK){DMA_K((t)+3,sl_cur);} if(GV){DMA_V((t)+1,sl_next);} \
    CMASK(C0,C1,t); \
    { float a=MX3(C0[0],C0[1],C1[0]),b=MX3(C0[2],C0[3],C1[1]); a=MX3(a,C1[2],C1[3]); \
      _Pragma("unroll") for(int r=4;r<16;r+=4){a=MX3(a,C0[r],C0[r+1]);b=MX3(b,C0[r+2],C0[r+3]);a=MX3(a,C1[r],C1[r+1]);b=MX3(b,C1[r+2],C1[r+3]);} \
      float rm=__builtin_fmaxf(a,b); { auto rr=__builtin_amdgcn_permlane32_swap(__float_as_uint(rm),__float_as_uint(rm),false,false); rm=__builtin_fmaxf(__uint_as_float(rr[0]),__uint_as_float(rr[1])); } \
      resc=false; \
      if(__builtin_expect(__any(rm>(float)THRL),0)){ const float dl=__builtin_fmaxf(rm,0.f); mhat+=dl; \
        _Pragma("unroll") for(int r=0;r<16;++r){C0[r]-=dl;C1[r]-=dl;} \
        const float f=__builtin_amdgcn_exp2f(-dl); l_reg*=f; if(hi==0)wsf[r32]=f; resc=true; } } \
    SBAR(); \
    GAPB(o[0]=__builtin_amdgcn_mfma_f32_32x32x16_bf16(PAF(0),VFR(0),o[0],0,0,0), C0,0); \
    GAPB(o[1]=__builtin_amdgcn_mfma_f32_32x32x16_bf16(PAF(0),VFR(4),o[1],0,0,0), C0,4); \
    KRD(GL,0); GAPB(o[0]=__builtin_amdgcn_mfma_f32_32x32x16_bf16(PAF(1),VFR(1),o[0],0,0,0), C0,8); \
    KRD(GL,1); GAPB(o[1]=__builtin_amdgcn_mfma_f32_32x32x16_bf16(PAF(1),VFR(5),o[1],0,0,0), C0,12); \
    KRD(GL,2); GAPB(o[0]=__builtin_amdgcn_mfma_f32_32x32x16_bf16(PAF(2),VFR(2),o[0],0,0,0), C1,0); \
    KRD(GL,3); GAPB(o[1]=__builtin_amdgcn_mfma_f32_32x32x16_bf16(PAF(2),VFR(6),o[1],0,0,0), C1,4); \
    GAPB(o[0]=__builtin_amdgcn_mfma_f32_32x32x16_bf16(PAF(3),VFR(3),o[0],0,0,0), C1,8); \
    GAPB(o[1]=__builtin_amdgcn_mfma_f32_32x32x16_bf16(PAF(3),VFR(7),o[1],0,0,0), C1,12); \
    }while(0)
  int t=1;
  #undef CMASK
  #define CMASK(P0,P1,t) do{}while(0)
  for(;t+5<NT;t+=2){
    STEP(pB0,pB1,pA0,pA1,t,true,true,true);     WAIT_BAR(2); RESC(); ROT();
    STEP(pA0,pA1,pB0,pB1,t+1,true,true,true);   WAIT_BAR(2); RESC(); ROT();
  }
  #undef CMASK
  #define CMASK(P0,P1,t) do{int jb_=(t)-(NT-4); if(jb_>=0)cmask(P0,P1,jb_,qrel,hi);}while(0)
  #define ENDW(tt) do{ if((tt)+3<NT){WAIT_BAR(2);} else if((tt)+2<NT){WAIT_BAR(1);} else {WAIT_BAR(0);} }while(0)
  for(;t+1<NT;t+=2){
    STEP(pB0,pB1,pA0,pA1,t,(t+3<NT),(t+1<NT),(t+1<NT));       ENDW(t);   RESC(); ROT();
    STEP(pA0,pA1,pB0,pB1,t+1,(t+4<NT),(t+2<NT),(t+2<NT));     ENDW(t+1); RESC(); ROT();
  }
  STEP(pB0,pB1,pA0,pA1,NT-1,false,false,false); RESC();
  { float sacc=pB0[0]+pB0[1]; _Pragma("unroll") for(int r=2;r<16;++r)sacc+=pB0[r]; _Pragma("unroll") for(int r=0;r<16;++r)sacc+=pB1[r]; l_reg+=sacc;
    pw0=(u32x4){PKW(pB0,0),PKW(pB0,2),PKW(pB0,4),PKW(pB0,6)};pw1=(u32x4){PKW(pB0,8),PKW(pB0,10),PKW(pB0,12),PKW(pB0,14)};pw2=(u32x4){PKW(pB1,0),PKW(pB1,2),PKW(pB1,4),PKW(pB1,6)};pw3=(u32x4){PKW(pB1,8),PKW(pB1,10),PKW(pB1,12),PKW(pB1,14)};
    SBAR(); pv(o,vb0+sl_cur,PAF(0),PAF(1),PAF(2),PAF(3)); }
  #undef PKW
  #undef PAF
  #undef VFR
  #undef PIN
  #undef MX3
  #undef GAPA
  #undef GAPB
  #undef EX
  #undef VRD
  #undef KRD
  #undef STEP
  #undef ENDW
  {auto rr=__builtin_amdgcn_permlane32_swap(__float_as_uint(l_reg),__float_as_uint(l_reg),false,false);l_reg=__uint_as_float(rr[0])+__uint_as_float(rr[1]);}
  if(hi==0)wsf[32+r32]=l_reg;asm volatile("s_waitcnt lgkmcnt(0)":::"memory");
  float rli[16];
  #pragma unroll
  for(int r=0;r<16;++r)rli[r]=__builtin_amdgcn_rcpf(wsf[32+crow(r,hi)]);
  bf16*Ow=O+(rowbase+q0+wid*QBLK)*DM+h*D;
  const bf16*Gw=GF+(rowbase+q0+wid*QBLK)*DM+h*D;
  { bf16*stg=(bf16*)(shm+LDS_OST)+wid*2048;
    #pragma unroll
    for(int r=0;r<16;++r){const int orow=crow(r,hi);
      #pragma unroll
      for(int d0=0;d0<2;++d0)stg[orow*64+d0*32+r32]=__float2bfloat16(o[d0][r]*rli[r]);}
    asm volatile("s_waitcnt lgkmcnt(0)":::"memory");
    u32x4 gg[4];
    #pragma unroll
    for(int i=0;i<4;++i){const int row=i*8+(lane>>3),ch=lane&7; gg[i]=*(const u32x4*)(Gw+(long)row*DM+ch*8);}
    #pragma unroll
    for(int i=0;i<4;++i){const int row=i*8+(lane>>3),ch=lane&7; const u32x4 v=*(const u32x4*)(stg+row*64+ch*8);
      *(u32x4*)(Ow+(long)row*DM+ch*8)=mul_bf16x8(v,gg[i]);} }
  asm volatile("s_waitcnt vmcnt(0) lgkmcnt(0)\n\ts_barrier":::"memory");
  #undef DMA_K
  #undef DMA_V
  #undef CMASK
  #undef START
  #undef RESC
  #undef ROT
}
constexpr int ATTN_LDS_BYTES=LDS_BYTES;
#undef SBAR
#undef WAIT_BAR
}

constexpr int NWAVES = 8;
constexpr size_t MiB = 1u << 20;
constexpr size_t WS_CTL = 0, CTL_ZERO_BYTES = 1 * MiB;
constexpr size_t WS_WIN = 2 * MiB, WS_WK = 25 * MiB, WS_WV = 27 * MiB, WS_WB = 29 * MiB, WS_WO = 35 * MiB, WS_WRF = 37 * MiB, WS_COEF = 37 * MiB + 512 * 1024;
constexpr size_t WS_MN = 38 * MiB, WS_MK = 42 * MiB, WS_MVT = 46 * MiB, WS_CB = 50 * MiB, WS_AGG = 54 * MiB, WS_SSP = 56 * MiB;
constexpr size_t WS_XN = 60 * MiB, WS_OUTB = 188 * MiB, WS_Z = 316 * MiB, WS_STASH = 668 * MiB, WS_MRG = 732 * MiB, WS_END = 796 * MiB;
static_assert(WS_WIN + (size_t)NIN * D * 2 <= WS_WK && WS_SSP + (size_t)MTOK * 16 * 4 <= WS_XN && WS_XN + (size_t)MTOK * D * 2 <= WS_OUTB && WS_OUTB + (size_t)MTOK * D * 2 <= WS_Z && WS_Z + (size_t)MC * NZC * 2 <= WS_END, "d_ws map");
constexpr int CW_BAR = 4096, CW_Q = 12288, CW_NRM = 16384;

constexpr int RING_OFF = 0, RING_BYTES = 131072;
constexpr int LDSCTL_OFF = RING_BYTES, MISC_OFF = LDSCTL_OFF + 320, XS_OFF = LDSCTL_OFF + 1024;
constexpr int LDS_BYTES = 147456;
static_assert(XS_OFF + 8192 <= LDS_BYTES && attn_body::ATTN_LDS_BYTES <= RING_BYTES, "LDS map");

#define GAS __attribute__((address_space(1)))
#define LAS __attribute__((address_space(3)))
typedef unsigned short bf16;
typedef unsigned v4u __attribute__((ext_vector_type(4)));
typedef unsigned v2u __attribute__((ext_vector_type(2)));
typedef float f32x4 __attribute__((ext_vector_type(4)));
typedef float f32x16 __attribute__((ext_vector_type(16)));
typedef short bf16x8 __attribute__((ext_vector_type(8)));
typedef GAS unsigned gu32;
#define LDS_WAIT() asm volatile("s_waitcnt lgkmcnt(0)" ::: "memory")
#define VM_WAIT() asm volatile("s_waitcnt vmcnt(0)" ::: "memory")
__device__ __forceinline__ unsigned f2bf(float f) { unsigned u = __builtin_bit_cast(unsigned, f); return (u + 0x7fffu + ((u >> 16) & 1u)) >> 16; }
__device__ __forceinline__ unsigned pk2(float lo, float hi) { return f2bf(lo) | (f2bf(hi) << 16); }

#define XB_TMO      128
#define XB_XCNT(j)  (256  + 64 * (j))
#define XB_XSUB(j)  (1280 + 64 * (j))
#define XB_XGEN(j)  (2304 + 64 * (j))
#define XB_TOP      3328
#define XB_TOPGEN   3392
#define XCD_BAR_WORDS 3456
#define XB_SPIN_CAP (1u << 22)
__device__ __forceinline__ unsigned xb_ld(unsigned* p)              { return __hip_atomic_load(p, __ATOMIC_RELAXED, __HIP_MEMORY_SCOPE_AGENT); }
__device__ __forceinline__ unsigned xb_add(unsigned* p, unsigned v) { return __hip_atomic_fetch_add(p, v, __ATOMIC_RELAXED, __HIP_MEMORY_SCOPE_AGENT); }
__device__ __forceinline__ unsigned xb_xcc_id() { return (unsigned)__builtin_amdgcn_s_getreg((3 << 11) | 20) & 0xFu; }
#define XB_SPIN(cond, bar) do { unsigned _sp = 0; while (cond) { __builtin_amdgcn_s_sleep(1); \
    if ((++_sp & 255u) == 0u) { if (xb_ld(&(bar)[XB_TMO])) break; if (_sp > XB_SPIN_CAP) { atomicAdd(&(bar)[XB_TMO], 1u); break; } } } } while (0)
struct XcdBarrier { unsigned* bar; unsigned x; volatile LAS unsigned* st; };
__device__ __forceinline__ XcdBarrier xcd_barrier_post(unsigned* bar, volatile LAS unsigned* st) {
    XcdBarrier b; b.bar = bar; b.x = xb_xcc_id(); b.st = st;
    if (threadIdx.x == 0) (void)xb_add(&bar[XB_XCNT(b.x)], 1u);
    return b;
}
__device__ __forceinline__ void xcd_barrier_complete(unsigned* bar, unsigned x, unsigned& nloc, unsigned& nx) {
    const unsigned G = gridDim.x * gridDim.y * gridDim.z;
    unsigned sum, cnt, mine, sp = 0u;
    for (;;) {
        sum = 0u; cnt = 0u; mine = 0u;
#pragma unroll
        for (unsigned j = 0; j < 16; ++j) { const unsigned c = xb_ld(&bar[XB_XCNT(j)]); sum += c; cnt += (c > 0u) ? 1u : 0u; mine = (j == x) ? c : mine; }
        if (sum == G) break;
        __builtin_amdgcn_s_sleep(1);
        if ((++sp & 255u) == 0u) { if (xb_ld(&bar[XB_TMO])) break; if (sp > XB_SPIN_CAP) { atomicAdd(&bar[XB_TMO], 1u); break; } }
    }
    nloc = mine > 0u ? mine : 1u; nx = cnt > 0u ? cnt : 1u;
}
__device__ __forceinline__ void xcd_barrier(const XcdBarrier& b) {
    asm volatile("s_waitcnt vmcnt(0)" ::: "memory");
    __syncthreads();
    if (threadIdx.x == 0) {
        unsigned* bar = b.bar;
        __builtin_amdgcn_s_waitcnt(0);
        unsigned nloc = b.st[0], nx = b.st[1];
        if (nloc == 0u) { xcd_barrier_complete(bar, b.x, nloc, nx); b.st[0] = nloc; b.st[1] = nx; }
        const unsigned old = xb_add(&bar[XB_XSUB(b.x)], 1u);
        const unsigned gen = old / nloc;
        if (old + 1u == (gen + 1u) * nloc) {
            __builtin_amdgcn_fence(__ATOMIC_RELEASE, "agent");
            asm volatile("s_waitcnt vmcnt(0)" ::: "memory");
            const unsigned og = xb_add(&bar[XB_TOP], 1u);
            const unsigned tg = og / nx;
            if (og + 1u == (tg + 1u) * nx) xb_add(&bar[XB_TOPGEN], 1u);
            else XB_SPIN(xb_ld(&bar[XB_TOPGEN]) == tg, bar);
            __builtin_amdgcn_fence(__ATOMIC_ACQUIRE, "agent");
            xb_add(&bar[XB_XGEN(b.x)], 1u);
            asm volatile("s_waitcnt vmcnt(0)" ::: "memory");
        } else {
            XB_SPIN(xb_ld(&bar[XB_XGEN(b.x)]) == gen, bar);
            __builtin_amdgcn_fence(__ATOMIC_ACQUIRE, "agent");
            asm volatile("s_waitcnt vmcnt(0)" ::: "memory");
        }
    }
    __syncthreads();
}

template <class T_> __device__ __forceinline__ T_* as_global(T_* p) { return (T_*)(GAS T_*)p; }
struct Args {
    const float *x, *mem, *g_pre, *w_in, *conv_w, *conv_b, *w_lru_r, *b_lru_r, *w_lru_i, *b_lru_i, *lru_lambda, *b_forget, *g_mem, *w_mem_k, *w_mem_v, *w_branch, *b_merge, *w_out, *g_post;
    float* out; unsigned char* ws;
};

__device__ __forceinline__ float wave_sum(float v, int lane) {
#pragma unroll
    for (int o = 1; o < 64; o <<= 1) v += __builtin_bit_cast(float, __builtin_amdgcn_ds_bpermute((lane ^ o) << 2, __builtin_bit_cast(int, v)));
    return v;
}
__device__ __forceinline__ void p0_transpose_item(const float* W, int ld, int K, int ncols, bf16* WT, LAS float* scr, int item, int lane) {
    const int nblk = ncols / 32, kb = item / nblk, nb = item % nblk, k0 = 64 * kb, n0 = 32 * nb;
#pragma unroll 8
    for (int i = 0; i < 32; ++i) { const int kk = 2 * i + (lane >> 5); scr[kk * 33 + (lane & 31)] = W[(size_t)(k0 + kk) * ld + n0 + (lane & 31)]; }
    LDS_WAIT(); asm volatile("" ::: "memory");
    const int c = lane & 7;
#pragma unroll
    for (int j = 0; j < 4; ++j) { const int n = (lane >> 3) + 8 * j; const LAS float* s = scr + (8 * c) * 33 + n;
        v4u o; o.x = pk2(s[0 * 33], s[1 * 33]); o.y = pk2(s[2 * 33], s[3 * 33]); o.z = pk2(s[4 * 33], s[5 * 33]); o.w = pk2(s[6 * 33], s[7 * 33]);
        *(GAS v4u*)(WT + (size_t)(n0 + n) * K + k0 + 8 * c) = o; }
    LDS_WAIT(); asm volatile("" ::: "memory");
}
__device__ __forceinline__ void rms_row_to_bf16(const float* xrow, const float* g, bf16* orow, int lane) {
    const GAS f32x4* xr = (const GAS f32x4*)xrow + lane; const GAS f32x4* gr = (const GAS f32x4*)g + lane;
    f32x4 v[4]; float s = 0.f;
#pragma unroll
    for (int j = 0; j < 4; ++j) { v[j] = xr[64 * j]; s += (v[j].x * v[j].x + v[j].y * v[j].y) + (v[j].z * v[j].z + v[j].w * v[j].w); }
    const float rs = 1.f / sqrtf(wave_sum(s, lane) * (1.f / D) + RMS_EPS);
    GAS unsigned long long* o8 = (GAS unsigned long long*)orow + lane;
#pragma unroll
    for (int j = 0; j < 4; ++j) { const f32x4 gg = gr[64 * j];
        o8[64 * j] = (unsigned long long)pk2(v[j].x * rs * gg.x, v[j].y * rs * gg.y) | ((unsigned long long)pk2(v[j].z * rs * gg.z, v[j].w * rs * gg.w) << 32); }
}

__device__ __forceinline__ void rms_rows4_to_bf16(const float* xrow, const float* g, bf16* orow, int lane) {
    const GAS f32x4* xr = (const GAS f32x4*)xrow + lane; const GAS f32x4* gr = (const GAS f32x4*)g + lane;
    f32x4 v[4][4]; float s[4] = {0.f, 0.f, 0.f, 0.f};
#pragma unroll
    for (int r = 0; r < 4; ++r)
#pragma unroll
        for (int j = 0; j < 4; ++j) v[r][j] = xr[r * (D / 4) + 64 * j];
#pragma unroll
    for (int r = 0; r < 4; ++r)
#pragma unroll
        for (int j = 0; j < 4; ++j) s[r] += (v[r][j].x * v[r][j].x + v[r][j].y * v[r][j].y) + (v[r][j].z * v[r][j].z + v[r][j].w * v[r][j].w);
#pragma unroll
    for (int r = 0; r < 4; ++r) { const float rs = 1.f / sqrtf(wave_sum(s[r], lane) * (1.f / D) + RMS_EPS);
        GAS unsigned long long* o8 = (GAS unsigned long long*)(orow + (size_t)r * D) + lane;
#pragma unroll
        for (int j = 0; j < 4; ++j) { const f32x4 gg = gr[64 * j];
            o8[64 * j] = (unsigned long long)pk2(v[r][j].x * rs * gg.x, v[r][j].y * rs * gg.y) | ((unsigned long long)pk2(v[r][j].z * rs * gg.z, v[r][j].w * rs * gg.w) << 32); } }
}
struct LruPtrs { const float *conv_w, *conv_b, *b_lru_r, *b_lru_i; unsigned char* ws; };
template <int PASS>
__device__ __forceinline__ void lru_unit(const LruPtrs& args, LAS unsigned char* lds, int chunk, int bl, int g, int ck) {
    int tid_ = threadIdx.x; asm volatile("" : "+v"(tid_));
    const int tid = tid_, lane = tid & 63, n = lane & 31, hi = lane >> 5; const int w = __builtin_amdgcn_readfirstlane(tid >> 6);
    unsigned char* ws = args.ws; asm volatile("" : "+s"(ws)); ws = as_global(ws);
    GAS bf16* Z = (GAS bf16*)(ws + WS_Z);
    GAS float* AGG = (GAS float*)(ws + WS_AGG);
    GAS v4u* stash = (GAS v4u*)(ws + WS_STASH) + ((size_t)((bl * 16 + g) * 32 + ck) * NWAVES + w) * 8 * 64 + lane;
    LAS float* WAG = (LAS float*)(lds + RING_OFF);
    LAS float* PART = (LAS float*)(lds + RING_OFF + 4096);
    LAS float* CARW = (LAS float*)(lds + RING_OFF + 8192);
    LAS float* PRM = (LAS float*)(lds + RING_OFF + 12288);
    const int tl = ck * 256 + w * 32 + n;
    const size_t zr = (size_t)bl * T + tl;
    const int cb0 = g * 64 + 4 * hi;
    float av[8][4], uv[8][4]; v4u gtile[4]; unsigned gagg[8];
    if (PASS == 1) {
        { const float* src = (w < 4) ? args.conv_w + w * D : (w == 4) ? args.conv_b : (w == 5) ? args.b_lru_r : (w == 6) ? args.b_lru_i : (const float*)(ws + WS_COEF);
          PRM[w * 64 + lane] = ((const GAS float*)src)[g * 64 + lane]; }
        LAS bf16* XT = (LAS bf16*)(lds + RING_OFF + 32768 + w * 4864);
        {
            const int tl0 = ck * 256 + w * 32;
            v4u xv[5];
#pragma unroll
            for (int i = 0; i < 5; ++i) { const int idx = lane + 64 * i, r = idx >> 3, ch = idx & 7; const int ts = tl0 - 3 + r;
                xv[i] = (v4u){0u, 0u, 0u, 0u};
                if (r < 35 && ts >= 0) xv[i] = *(const GAS v4u*)(Z + ((size_t)bl * T + ts) * LDZ + ZC_AX + g * 64 + ch * 8); }
#pragma unroll
            for (int i = 0; i < 5; ++i) { const int idx = lane + 64 * i, r = idx >> 3, ch = idx & 7;
                if (r < 35) { *(LAS v2u*)(XT + r * 68 + ch * 8) = (v2u){xv[i].x, xv[i].y}; *(LAS v2u*)(XT + r * 68 + ch * 8 + 4) = (v2u){xv[i].z, xv[i].w}; } }
        }
        __syncthreads();
        v2u xw[4][8];
#pragma unroll
        for (int k = 0; k < 4; ++k)
#pragma unroll
            for (int q = 0; q < 8; ++q) xw[k][q] = *(const LAS v2u*)(XT + (n + k) * 68 + 8 * q + 4 * hi);
        float xc[8][4];
#pragma unroll
        for (int q = 0; q < 8; ++q) { const f32x4 bb = *(const LAS f32x4*)(PRM + 4 * 64 + 8 * q + 4 * hi);
#pragma unroll
            for (int p = 0; p < 4; ++p) xc[q][p] = bb[p]; }
#pragma unroll
        for (int k = 0; k < 4; ++k) {
#pragma unroll
            for (int q = 0; q < 8; ++q) { const f32x4 cw = *(const LAS f32x4*)(PRM + k * 64 + 8 * q + 4 * hi);
                xc[q][0] += cw[0] * pg8::bf_lo(xw[k][q].x); xc[q][1] += cw[1] * pg8::bf_hi(xw[k][q].x); xc[q][2] += cw[2] * pg8::bf_lo(xw[k][q].y); xc[q][3] += cw[3] * pg8::bf_hi(xw[k][q].y); }
        }
        f32x16 ar[2], ai_[2];
#pragma unroll
        for (int rb = 0; rb < 2; ++rb) { ar[rb] = f32x16{}; ai_[rb] = f32x16{}; }
        const GAS bf16* wrf = (const GAS bf16*)(ws + WS_WRF) + (size_t)g * (2 * 2 * 4 * 64 * 8) + lane * 8;
#pragma unroll
        for (int ks = 0; ks < 4; ++ks) {
            v4u bw; bw.x = pg8::cvt_pk_bf16(xc[2 * ks][0], xc[2 * ks][1]); bw.y = pg8::cvt_pk_bf16(xc[2 * ks][2], xc[2 * ks][3]); bw.z = pg8::cvt_pk_bf16(xc[2 * ks + 1][0], xc[2 * ks + 1][1]); bw.w = pg8::cvt_pk_bf16(xc[2 * ks + 1][2], xc[2 * ks + 1][3]);
            const bf16x8 bfr = __builtin_bit_cast(bf16x8, bw);
#pragma unroll
            for (int rb = 0; rb < 2; ++rb) {
                const bf16x8 wr_ = __builtin_bit_cast(bf16x8, *(const GAS v4u*)(wrf + ((0 * 2 + rb) * 4 + ks) * 512));
                const bf16x8 wi_ = __builtin_bit_cast(bf16x8, *(const GAS v4u*)(wrf + ((1 * 2 + rb) * 4 + ks) * 512));
                ar[rb] = __builtin_amdgcn_mfma_f32_32x32x16_bf16(wr_, bfr, ar[rb], 0, 0, 0);
                ai_[rb] = __builtin_amdgcn_mfma_f32_32x32x16_bf16(wi_, bfr, ai_[rb], 0, 0, 0);
            }
        }
#pragma unroll
        for (int q = 0; q < 8; ++q) {
            const f32x4 br = *(const LAS f32x4*)(PRM + 5 * 64 + 8 * q + 4 * hi), bi = *(const LAS f32x4*)(PRM + 6 * 64 + 8 * q + 4 * hi), cf = *(const LAS f32x4*)(PRM + 7 * 64 + 8 * q + 4 * hi);
#pragma unroll
            for (int p = 0; p < 4; ++p) { const int rb = q >> 2, r = (q & 3) * 4 + p;
                const float rr = pg8::sigm(ar[rb][r] + br[p]), ii = pg8::sigm(ai_[rb][r] + bi[p]);
                const float a0 = __builtin_amdgcn_exp2f(cf[p] * rr);
                av[q][p] = a0; uv[q][p] = __builtin_amdgcn_sqrtf(fmaxf(1.f - a0 * a0, 0.f)) * (ii * xc[q][p]); }
        }
    } else {
#pragma unroll
        for (int i = 0; i < 4; ++i) { const int idx = lane + 64 * i, r = idx >> 3, ch = idx & 7;
            gtile[i] = *(const GAS v4u*)(Z + ((size_t)bl * T + ck * 256 + w * 32 + r) * LDZ + ZC_GA + g * 64 + ch * 8); }
#pragma unroll
        for (int q = 0; q < 8; ++q) { const v4u st = stash[q * 64];
#pragma unroll
            for (int p = 0; p < 4; ++p) { av[q][p] = pg8::bf_lo(st[p]); uv[q][p] = pg8::bf_hi(st[p]); } }
        if (w == 0) { const GAS unsigned* gs = (const GAS unsigned*)((GAS v4u*)(ws + WS_STASH) + ((size_t)((bl * 16 + g) * 32 + ck) * NWAVES) * 8 * 64);
#pragma unroll
            for (int ww = 0; ww < 8; ++ww) gagg[ww] = gs[(size_t)((ww * 8 + (lane >> 3)) * 64 + 31 + 32 * ((lane >> 2) & 1)) * 4 + (lane & 3)]; }
    }
    float pA = 1.f, pH = 0.f;
    if (PASS == 3) { typedef float f32x2v __attribute__((ext_vector_type(2))); f32x2v ag[4];
#pragma unroll
        for (int j = 0; j < 4; ++j) { const int cc = 4 * w + j; ag[j] = (f32x2v){1.f, 0.f}; if (cc < ck) ag[j] = *(const GAS f32x2v*)(AGG + ((size_t)(bl * 32 + cc) * D + g * 64 + lane) * 2); }
#pragma unroll
        for (int j = 0; j < 4; ++j) { pH = ag[j].x * pH + ag[j].y; pA = pA * ag[j].x; } }
#define LRU_STEP(CTRL) \
        "v_fmac_f32_dpp %0, %0, %1 " CTRL "\n\tv_fmac_f32_dpp %2, %2, %3 " CTRL "\n\tv_fmac_f32_dpp %4, %4, %5 " CTRL "\n\tv_fmac_f32_dpp %6, %6, %7 " CTRL "\n\t" \
        "v_mul_f32_dpp %1, %1, %1 " CTRL "\n\tv_mul_f32_dpp %3, %3, %3 " CTRL "\n\tv_mul_f32_dpp %5, %5, %5 " CTRL "\n\tv_mul_f32_dpp %7, %7, %7 " CTRL "\n\t"
    if (PASS == 1) {
#pragma unroll
    for (int q = 0; q < 8; ++q)
        asm volatile("s_nop 1\n\t"
            LRU_STEP("row_shr:1 row_mask:0xf bank_mask:0xf") LRU_STEP("row_shr:2 row_mask:0xf bank_mask:0xf") LRU_STEP("row_shr:4 row_mask:0xf bank_mask:0xf")
            LRU_STEP("row_shr:8 row_mask:0xf bank_mask:0xf") LRU_STEP("row_bcast:15 row_mask:0xa bank_mask:0xf")
            : "+v"(uv[q][0]), "+v"(av[q][0]), "+v"(uv[q][1]), "+v"(av[q][1]), "+v"(uv[q][2]), "+v"(av[q][2]), "+v"(uv[q][3]), "+v"(av[q][3]));
#pragma unroll
    for (int q = 0; q < 8; ++q) { v4u st;
#pragma unroll
        for (int p = 0; p < 4; ++p) st[p] = pg8::cvt_pk_bf16(av[q][p], uv[q][p]);
        stash[q * 64] = st; }
    }
#undef LRU_STEP
    if (PASS == 1 && n == 31) {
#pragma unroll
        for (int q = 0; q < 8; ++q)
#pragma unroll
            for (int p = 0; p < 4; ++p) { const int ci = 8 * q + 4 * hi + p; WAG[(w * 64 + ci) * 2] = av[q][p]; WAG[(w * 64 + ci) * 2 + 1] = uv[q][p]; }
    }
    if (PASS == 3) { PART[(w * 64 + lane) * 2] = pA; PART[(w * 64 + lane) * 2 + 1] = pH; }
    __syncthreads();
    if (PASS == 1) {
        if (w == 0) { float A = 1.f, H = 0.f;
#pragma unroll
            for (int ww = 0; ww < 8; ++ww) { const float a = WAG[(ww * 64 + lane) * 2], h = WAG[(ww * 64 + lane) * 2 + 1]; H = a * H + h; A = A * a; }
            GAS float* dst = AGG + ((size_t)(bl * 32 + ck) * D + g * 64 + lane) * 2; dst[0] = A; dst[1] = H; }
        __syncthreads();
    } else {
        if (w == 0) { float H = 0.f;
#pragma unroll
            for (int ww = 0; ww < 8; ++ww) H = PART[(ww * 64 + lane) * 2] * H + PART[(ww * 64 + lane) * 2 + 1];
#pragma unroll
            for (int ww = 0; ww < 8; ++ww) { CARW[ww * 64 + lane] = H; H = pg8::bf_lo(gagg[ww]) * H + pg8::bf_hi(gagg[ww]); } }
        __syncthreads();
        LAS bf16* GT = (LAS bf16*)(lds + RING_OFF + 32768 + w * 4864);
#pragma unroll
        for (int i = 0; i < 4; ++i) { const int idx = lane + 64 * i, r = idx >> 3, ch = idx & 7;
            *(LAS v2u*)(GT + r * 68 + ch * 8) = (v2u){gtile[i].x, gtile[i].y}; *(LAS v2u*)(GT + r * 68 + ch * 8 + 4) = (v2u){gtile[i].z, gtile[i].w}; }
        asm volatile("s_waitcnt lgkmcnt(0)" ::: "memory");
#pragma unroll
        for (int q = 0; q < 8; ++q) { const f32x4 cr = *(const LAS f32x4*)(CARW + w * 64 + 8 * q + 4 * hi);
            LAS v2u* gl = (LAS v2u*)(GT + n * 68 + 8 * q + 4 * hi);
            const v2u gw = *gl;
            const float h0 = (uv[q][0] + av[q][0] * cr[0]) * pg8::bf_lo(gw.x), h1 = (uv[q][1] + av[q][1] * cr[1]) * pg8::bf_hi(gw.x);
            const float h2 = (uv[q][2] + av[q][2] * cr[2]) * pg8::bf_lo(gw.y), h3 = (uv[q][3] + av[q][3] * cr[3]) * pg8::bf_hi(gw.y);
            v2u o; o.x = pg8::cvt_pk_bf16(h0, h1); o.y = pg8::cvt_pk_bf16(h2, h3); *gl = o; }
        asm volatile("s_waitcnt lgkmcnt(0)" ::: "memory");
#pragma unroll
        for (int i = 0; i < 4; ++i) { const int idx = lane + 64 * i, r = idx >> 3, ch = idx & 7;
            const v2u a = *(const LAS v2u*)(GT + r * 68 + ch * 8), b = *(const LAS v2u*)(GT + r * 68 + ch * 8 + 4);
            *(GAS v4u*)(Z + ((size_t)bl * T + ck * 256 + w * 32 + r) * LDZ + ZC_GA + g * 64 + ch * 8) = (v4u){a.x, a.y, b.x, b.y}; }
        __syncthreads();
    }
}

__device__ __forceinline__ void cumsum_unit(float* CBh, LAS unsigned char* lds) {
    int tid_ = threadIdx.x; asm volatile("" : "+v"(tid_));
    const int tid = tid_, lane = tid & 63, w = tid >> 6;
    LAS float* wsum = (LAS float*)(lds + RING_OFF + 16384);
    f32x4 v[4]; float s = 0.f;
#pragma unroll
    for (int j = 0; j < 4; ++j) { v[j] = *(const f32x4*)(CBh + tid * 16 + 4 * j);
#pragma unroll
        for (int e = 0; e < 4; ++e) { s += v[j][e]; v[j][e] = s; } }
    float inc = s;
#pragma unroll
    for (int d = 1; d < 64; d <<= 1) { const float o = __builtin_bit_cast(float, __builtin_amdgcn_ds_bpermute((lane - d) << 2, __builtin_bit_cast(int, inc))); if (lane >= d) inc += o; }
    if (lane == 63) wsum[w] = inc;
    __syncthreads();
    float off = inc - s;
    for (int ww = 0; ww < w; ++ww) off += wsum[ww];
#pragma unroll
    for (int j = 0; j < 4; ++j) { f32x4 o;
#pragma unroll
        for (int e = 0; e < 4; ++e) o[e] = -(off + v[j][e]) * LOG2E;
        *(f32x4*)(CBh + tid * 16 + 4 * j) = o; }
    __syncthreads();
}

struct SchedIn { pg8::TileOrder o; const bf16* XNc; const bf16* WinT; bf16* Z;
    __device__ __forceinline__ bool next(int i, pg8::Unit& u) const { int pm, pn; if (!o.map(i, pm, pn)) return false; u.pm = pm; u.pn = pn; u.z = 0; u.ldo = LDZ;
        u.A = XNc + (size_t)pm * 256 * D; u.B = WinT + (size_t)pn * 256 * D; u.O = Z + (size_t)(pn >> 2) * ZBLK + (size_t)pm * 256 * LDZ + (pn & 3) * 256; u.G = nullptr; return true; } };
struct SchedMemKV { int q; const bf16 *MN, *WkT, *WvT; bf16 *MK, *MVT;
    __device__ __forceinline__ bool next(int i, pg8::Unit& u) const { if (i > 0 || q < 0 || q >= 64) return false; u.z = 0; u.G = nullptr;
        if (q < 32) { const int pm = q >> 2, pn = q & 3; u.pm = pm; u.pn = pn; u.A = MN + (size_t)pm * 256 * D; u.B = WkT + (size_t)pn * 256 * D; u.O = MK + (size_t)pm * 256 * D + pn * 256; u.ldo = D; }
        else { const int b = (q - 32) >> 2, pm = (q - 32) & 3; u.pm = pm; u.pn = 0; u.A = WvT + (size_t)pm * 256 * D; u.B = MN + (size_t)b * MEMLEN * D; u.O = MVT + (size_t)b * D * MEMLEN + (size_t)pm * 256 * MEMLEN; u.ldo = MEMLEN; }
        return true; } };
struct SchedMemS { int G, c, chunk; bf16* Z; const bf16* MK;
    __device__ __forceinline__ bool next(int i, pg8::Unit& u) const { const int L = i * G + c; if (L >= 256) return false; const int bl = L >> 7, h = (L >> 5) & 3, pmb = L & 31;
        const size_t r0 = (size_t)bl * T + pmb * 256; u.pm = pmb; u.pn = 0; u.z = 0; u.ldo = LDZ;
        u.A = Z + r0 * LDZ + ZC_MQ + h * 256; u.B = MK + (size_t)((chunk * CHB + bl) * MEMLEN) * D + h * 256; u.O = Z + r0 * LDZ + ZC_MQ + h * 256; u.G = nullptr; return true; } };
struct SchedMemPV { int G, c, chunk; bf16* Z; const bf16* MVT;
    __device__ __forceinline__ bool next(int i, pg8::Unit& u) const { const int L = i * G + c; if (L >= 256) return false; const int bl = L >> 7, h = (L >> 5) & 3, pmb = L & 31;
        const size_t r0 = (size_t)bl * T + pmb * 256; u.pm = pmb; u.pn = 0; u.z = 0; u.ldo = LDZ;
        u.A = Z + r0 * LDZ + ZC_MQ + h * 256; u.B = MVT + (size_t)(chunk * CHB + bl) * D * MEMLEN + (size_t)h * 256 * MEMLEN; u.O = Z + r0 * LDZ + ZC_MQ + h * 256; u.G = Z + r0 * LDZ + ZC_GM + h * 256; return true; } };
struct SchedMerge { pg8::TileOrder o; bf16* Z; const bf16* WBt; bf16* MRG;
    __device__ __forceinline__ bool next(int i, pg8::Unit& u) const { int pm, pn; if (!o.map(i / 3, pm, pn)) return false; const int nb = i % 3; u.pm = pm; u.pn = pn; u.z = nb; u.ldo = LDZ;
        const size_t acol = nb == 0 ? ZC_GA : nb == 1 ? ZC_Q : ZC_MQ;
        u.A = Z + (size_t)pm * 256 * LDZ + acol; u.B = WBt + (size_t)nb * D * D + (size_t)pn * 256 * D; u.O = MRG + (size_t)pm * 256 * D + pn * 256; u.ldo = D; u.G = Z + (size_t)pm * 256 * LDZ + ZC_MG + (size_t)nb * ZBLK + pn * 256; return true; } };
struct SchedOut { pg8::TileOrder o; const bf16* MRG; const bf16* WoT; bf16* OUTB; int chunk;
    __device__ __forceinline__ bool next(int i, pg8::Unit& u) const { int pm, pn; if (!o.map(i, pm, pn)) return false; u.pm = pm; u.pn = pn; u.z = chunk * MC + pm * 256; u.ldo = D;
        u.A = MRG + (size_t)pm * 256 * D; u.B = WoT + (size_t)pn * 256 * D; u.O = OUTB + (size_t)(chunk * MC + pm * 256) * D + pn * 256; u.G = nullptr; return true; } };

__global__ void __launch_bounds__(NWAVES * 64, 2) hybrid_fwd(Args args) {
    extern __shared__ __attribute__((aligned(16))) unsigned char lds_raw[];
    LAS unsigned char* lds = (LAS unsigned char*)lds_raw;
    volatile LAS unsigned* MISC = (volatile LAS unsigned*)(lds + MISC_OFF);
    const int tid = threadIdx.x, lane = tid & 63, wave = __builtin_amdgcn_readfirstlane(tid >> 6);
    const int G = gridDim.x, c = blockIdx.x;
    typedef const __attribute__((address_space(4))) Args* KArgs;
#define KA() ({ KArgs p_ = (KArgs)__builtin_amdgcn_kernarg_segment_ptr(); asm volatile("" : "+s"(p_)); p_; })
    unsigned char* ws = KA()->ws;
    gu32* ctl = (gu32*)(ws + WS_CTL);
    bf16* WinT = (bf16*)(ws + WS_WIN); bf16* WkT = (bf16*)(ws + WS_WK); bf16* WvT = (bf16*)(ws + WS_WV); bf16* WBt = (bf16*)(ws + WS_WB); bf16* WoT = (bf16*)(ws + WS_WO);
    bf16* MN = (bf16*)(ws + WS_MN); bf16* MK = (bf16*)(ws + WS_MK); bf16* MVT = (bf16*)(ws + WS_MVT);
    float* CB = (float*)(ws + WS_CB); float* SSP = (float*)(ws + WS_SSP);
    bf16* XN = (bf16*)(ws + WS_XN); bf16* OUTB = (bf16*)(ws + WS_OUTB); bf16* Z = (bf16*)(ws + WS_Z);
    for (int u = tid; u < (LDS_BYTES - LDSCTL_OFF) / 4; u += NWAVES * 64) ((LAS unsigned*)(lds + LDSCTL_OFF))[u] = 0u;
    __syncthreads();
    (void)xcd_barrier_post((unsigned*)(ctl + CW_BAR), MISC + 8);
#define GRID_BAR() do { XcdBarrier bar_; bar_.bar = (unsigned*)(KA()->ws + WS_CTL) + CW_BAR; bar_.x = xb_xcc_id(); bar_.st = MISC + 8; xcd_barrier(bar_); } while (0)

    {
        KArgs args = KA();
        LAS float* scr = (LAS float*)(lds + RING_OFF + wave * 16384);
        const int gw = c * NWAVES + wave, NGW = G * NWAVES;
        constexpr int I_A = 16 * (5120 / 32), I_B = 16 * (6144 / 32), I_S = 16 * 32;
        constexpr int NITEMS = I_A + I_B + 6 * I_S;
        for (int it = gw; it < NITEMS; it += NGW) {
            int r = it;
            if (r < I_A) { p0_transpose_item(args->w_in, IN_COLS, D, 5120, WinT, scr, r, lane); continue; } r -= I_A;
            if (r < I_B) { p0_transpose_item(args->w_in + 5136, IN_COLS, D, 6144, WinT + (size_t)5120 * D, scr, r, lane); continue; } r -= I_B;
            if (r < I_S) { p0_transpose_item(args->w_mem_k, D, D, D, WkT, scr, r, lane); continue; } r -= I_S;
            if (r < I_S) { p0_transpose_item(args->w_mem_v, D, D, D, WvT, scr, r, lane); continue; } r -= I_S;
            if (r < 3 * I_S) { const int nb = r / I_S; p0_transpose_item(args->w_branch + (size_t)nb * D * D, D, D, D, WBt + (size_t)nb * D * D, scr, r % I_S, lane); continue; } r -= 3 * I_S;
            p0_transpose_item(args->w_out, D, D, D, WoT, scr, r, lane);
        }
        const int gt = c * (NWAVES * 64) + tid, NGT = G * NWAVES * 64;
        for (int e = gt; e < 256 * 128; e += NGT) { const int row = e >> 7, k8 = (e & 127) * 8; v4u o = (v4u){0u, 0u, 0u, 0u};
            if (row < 16) { const float* s = args->w_in + (size_t)k8 * IN_COLS + 5120 + row;
                o.x = pk2(s[0], s[IN_COLS]); o.y = pk2(s[2 * IN_COLS], s[3 * IN_COLS]); o.z = pk2(s[4 * IN_COLS], s[5 * IN_COLS]); o.w = pk2(s[6 * IN_COLS], s[7 * IN_COLS]); }
            *(v4u*)(WinT + (size_t)(NZC + row) * D + k8) = o; }
        for (int e = gt; e < 16 * 2 * 2 * 4 * 64; e += NGT) { const int ln = e & 63, ks = (e >> 6) & 3, rb = (e >> 8) & 1, mat = (e >> 9) & 1, gg = e >> 10;
            const float* Wm = (mat ? args->w_lru_i : args->w_lru_r) + (size_t)gg * 64 * 64; const int j = 32 * rb + (ln & 31), hh = ln >> 5;
            float f[8];
#pragma unroll
            for (int q = 0; q < 8; ++q) { const int k = 8 * (2 * ks + (q >> 2)) + 4 * hh + (q & 3); f[q] = Wm[k * 64 + j]; }
            v4u o; o.x = pk2(f[0], f[1]); o.y = pk2(f[2], f[3]); o.z = pk2(f[4], f[5]); o.w = pk2(f[6], f[7]);
            *(v4u*)((bf16*)(ws + WS_WRF) + (size_t)e * 8) = o; }
        for (int e = gt; e < D; e += NGT) { const float x = -args->lru_lambda[e]; const float sp = fmaxf(x, 0.f) + log1pf(expf(-fabsf(x))); ((float*)(ws + WS_COEF))[e] = -8.f * sp * LOG2E; }
        { const float* xg0 = as_global(args->x); const float* gp0 = as_global(args->g_pre);
          for (int m = 4 * gw; m < MTOK; m += 4 * NGW) rms_rows4_to_bf16(xg0 + (size_t)m * D, gp0, XN + (size_t)m * D, lane); }
        for (int m = gw; m < NB * MEMLEN; m += NGW) rms_row_to_bf16(args->mem + (size_t)m * D, args->g_mem, MN + (size_t)m * D, lane);
    }
    if (gridDim.y != 1) cg::this_grid().sync();
    GRID_BAR();
    {
        KArgs args = KA(); const float* bfg = as_global(args->b_forget);
        const GAS bf16* XNg = (const GAS bf16*)(as_global(args->ws) + WS_XN); const GAS bf16* Wf = (const GAS bf16*)(as_global(args->ws) + WS_WIN) + (size_t)NZC * D;
        GAS float* LFt = (GAS float*)(as_global(args->ws) + WS_CB);
        int tid_ = threadIdx.x; asm volatile("" : "+v"(tid_)); const int ln = tid_ & 63, r32 = ln & 31, hi = ln >> 5, wv = __builtin_amdgcn_readfirstlane(tid_ >> 6);
        const bool kvcu = (G >= 192 && c >= 64 && c < 128);
        const int cc = !(G >= 192) ? c : (c < 64 ? c : c - 64), GG = (G >= 192) ? G - 64 : G;
        for (int it = kvcu ? MTOK : cc * NWAVES + wv; it < MTOK / 32; it += GG * NWAVES) {
            const GAS bf16* ap = XNg + (size_t)(it * 32 + r32) * D + 8 * hi; const GAS bf16* bp = Wf + (size_t)r32 * D + 8 * hi;
            f32x16 acc = f32x16{};
#pragma unroll 8
            for (int ks = 0; ks < 64; ++ks) { const bf16x8 af = __builtin_bit_cast(bf16x8, *(const GAS v4u*)(ap + 16 * ks)), bfv = __builtin_bit_cast(bf16x8, *(const GAS v4u*)(bp + 16 * ks));
                acc = __builtin_amdgcn_mfma_f32_32x32x16_bf16(af, bfv, acc, 0, 0, 0); }
            if (r32 < 16) { const float bb = bfg[r32]; const int tok = it * 32, bg = tok >> 13, t = tok & (T - 1);
#pragma unroll
                for (int g4 = 0; g4 < 4; ++g4) { f32x4 o;
#pragma unroll
                    for (int e = 0; e < 4; ++e) { const float x = acc[4 * g4 + e] + bb; o[e] = fminf(x, 0.f) - log1pf(__expf(-fabsf(x))); }
                    *(GAS f32x4*)(LFt + (size_t)(bg * 16 + r32) * T + t + 8 * g4 + 4 * hi) = o; } }
        }
        {
            unsigned char* wsk = as_global(args->ws);
            pg8::Gemm g{D, D, D}; SchedMemKV S2{(G >= 192) ? (kvcu ? c - 64 : -1) : ((c < 64) ? c : -1), (const bf16*)(wsk + WS_MN), (const bf16*)(wsk + WS_WK), (const bf16*)(wsk + WS_WV), (bf16*)(wsk + WS_MK), (bf16*)(wsk + WS_MVT)}; pg8::EpiStore E2;
            if (G >= 64) pg8::gemm_phase<pg8::EpiStore, SchedMemKV>(lds + RING_OFF, g, S2, E2);
        }
    }

    for (int chunk = 0; chunk < NCHUNK; ++chunk) {
        unsigned char* wsl = as_global(KA()->ws);
        int c = blockIdx.x, G = gridDim.x; asm volatile("" : "+s"(c), "+s"(G));
        bf16* WinT = (bf16*)(wsl + WS_WIN); bf16* WkT = (bf16*)(wsl + WS_WK); bf16* WvT = (bf16*)(wsl + WS_WV); bf16* WBt = (bf16*)(wsl + WS_WB); bf16* WoT = (bf16*)(wsl + WS_WO);
        bf16* MN = (bf16*)(wsl + WS_MN); bf16* MK = (bf16*)(wsl + WS_MK); bf16* MVT = (bf16*)(wsl + WS_MVT);
        float* CB = (float*)(wsl + WS_CB); float* SSP = (float*)(wsl + WS_SSP); unsigned* NRM = (unsigned*)(wsl + WS_CTL) + CW_NRM;
        bf16* XN = (bf16*)(wsl + WS_XN); bf16* OUTB = (bf16*)(wsl + WS_OUTB); bf16* Z = (bf16*)(wsl + WS_Z);
        {
            pg8::Gemm g{D, D, D}; SchedIn S; S.o.init(MC / 256, NZT, G, c); S.XNc = XN + (size_t)chunk * MC * D; S.WinT = WinT; S.Z = Z;
            pg8::EpiIn E{as_global(KA()->b_merge), chunk * MC, NRM};
            pg8::gemm_phase<pg8::EpiIn, SchedIn>(lds + RING_OFF, g, S, E);
        }
        GRID_BAR();
        {
            {
                KArgs ka = KA(); const LruPtrs lp{as_global(ka->conv_w), as_global(ka->conv_b), as_global(ka->b_lru_r), as_global(ka->b_lru_i), as_global(ka->ws)};
                unsigned* qc = (unsigned*)(wsl + WS_CTL) + CW_Q + (chunk * 2 + 0) * 64; LAS unsigned* slot = (LAS unsigned*)(lds + LDSCTL_OFF + 64);
                for (;;) {
                    if (threadIdx.x == 0) *slot = __hip_atomic_fetch_add(qc, 1u, __ATOMIC_RELAXED, __HIP_MEMORY_SCOPE_AGENT);
                    __syncthreads();
                    const int L = __builtin_amdgcn_readfirstlane((int)*slot);
                    __syncthreads();
                    if (L >= CHB * 16 * 32 + CHB * 16) break;
                    if (L >= CHB * 16) { const int L1 = L - CHB * 16; lru_unit<1>(lp, lds, chunk, L1 >> 9, (L1 >> 5) & 15, L1 & 31); }
                    else cumsum_unit(CB + (size_t)(chunk * CHB * 16 + L) * T, lds);
                }
            }
            pg8::Gemm g{LDZ, D, 256}; SchedMemS S{G, c, chunk, Z, MK}; pg8::EpiSoftmax E{(PG8_LAS float*)(lds + XS_OFF)};
            pg8::gemm_phase<pg8::EpiSoftmax, SchedMemS>(lds + RING_OFF, g, S, E);
        }
        GRID_BAR();
        {
            {
                KArgs ka = KA(); const LruPtrs lp{as_global(ka->conv_w), as_global(ka->conv_b), as_global(ka->b_lru_r), as_global(ka->b_lru_i), as_global(ka->ws)};
                unsigned* qc = (unsigned*)(wsl + WS_CTL) + CW_Q + (chunk * 2 + 1) * 64; LAS unsigned* slot = (LAS unsigned*)(lds + LDSCTL_OFF + 64);
                for (;;) {
                    if (threadIdx.x == 0) *slot = __hip_atomic_fetch_add(qc, 1u, __ATOMIC_RELAXED, __HIP_MEMORY_SCOPE_AGENT);
                    __syncthreads();
                    const int L = __builtin_amdgcn_readfirstlane((int)*slot);
                    __syncthreads();
                    if (L >= 2 * CHB * 16 * 32) break;
                    if (L < CHB * 16 * 32) { const int qb = 31 - (L >> 5), bh = L & 31;
                        attn_body::attn_unit<48>(bh / 16, bh % 16, qb, (const attn_body::bf16*)(Z + ZC_Q), (const attn_body::bf16*)(Z + ZC_K), (const attn_body::bf16*)(Z + ZC_V), (attn_body::bf16*)(Z + ZC_Q),
                                                (const attn_body::bf16*)(Z + ZC_GF), CB + (size_t)(chunk * CHB * 16 + bh) * T, NRM + (chunk * CHB * 16 + bh) * 2, NRM + 1024 + ((chunk * CHB * 16 + bh) * 32 + qb) * 2, (char*)lds_raw + RING_OFF); }
                    else { const int L3 = L - CHB * 16 * 32; lru_unit<3>(lp, lds, chunk, L3 >> 9, (L3 >> 5) & 15, L3 & 31); }
                }
            }
            pg8::Gemm g{LDZ, MEMLEN, 256}; SchedMemPV S{G, c, chunk, Z, MVT}; pg8::EpiMul E;
            pg8::gemm_phase<pg8::EpiMul, SchedMemPV>(lds + RING_OFF, g, S, E);
        }
        GRID_BAR();
        {
            pg8::Gemm g{LDZ, D, D}; SchedMerge S; S.o.init(MC / 256, D / 256, G, c); S.Z = Z; S.WBt = WBt; S.MRG = (bf16*)(wsl + WS_MRG) + (size_t)(chunk & 1) * MC * D; pg8::EpiMerge E;
            pg8::gemm_phase<pg8::EpiMerge, SchedMerge>(lds + RING_OFF, g, S, E);
        }
        GRID_BAR();
        {
            pg8::Gemm g{D, D, D}; SchedOut S; S.o.init(MC / 256, D / 256, G, c); S.MRG = (const bf16*)(wsl + WS_MRG) + (size_t)(chunk & 1) * MC * D; S.WoT = WoT; S.OUTB = OUTB; S.chunk = chunk; pg8::EpiOut E{SSP};
            pg8::gemm_phase<pg8::EpiOut, SchedOut>(lds + RING_OFF, g, S, E);
        }
        if (chunk + 1 == NCHUNK) GRID_BAR();
    }
    {
        KArgs args = KA();
        const float* SSP = (const float*)(as_global(args->ws) + WS_SSP); const bf16* OUTB = (const bf16*)(as_global(args->ws) + WS_OUTB);
        const float* xg_ = as_global(args->x); const float* gpost_ = as_global(args->g_post); float* outg_ = as_global(args->out);
        int tid_ = threadIdx.x; asm volatile("" : "+v"(tid_)); const int lane = tid_ & 63, wave = __builtin_amdgcn_readfirstlane(tid_ >> 6);
        const int gw = c * NWAVES + wave, NGW = G * NWAVES;
        for (int m = 2 * gw; m < MTOK; m += 2 * NGW) {
            f32x4 xv[2][4]; v2u ow[2][4]; float sp[2];
#pragma unroll
            for (int r = 0; r < 2; ++r) { sp[r] = (lane < 16) ? ((const GAS float*)SSP)[(size_t)(m + r) * 16 + lane] : 0.f;
                const GAS f32x4* xr = (const GAS f32x4*)(xg_ + (size_t)(m + r) * D) + lane; const GAS v2u* orow = (const GAS v2u*)(OUTB + (size_t)(m + r) * D) + lane;
#pragma unroll
                for (int j = 0; j < 4; ++j) { xv[r][j] = xr[64 * j]; ow[r][j] = orow[64 * j]; } }
#pragma unroll
            for (int r = 0; r < 2; ++r) { const float rs = 1.f / sqrtf(wave_sum(sp[r], lane) * (1.f / D) + RMS_EPS);
                const GAS f32x4* gr = (const GAS f32x4*)gpost_ + lane; GAS f32x4* yr = (GAS f32x4*)(outg_ + (size_t)(m + r) * D) + lane;
#pragma unroll
                for (int j = 0; j < 4; ++j) { const f32x4 gg = gr[64 * j]; f32x4 y;
                    y.x = xv[r][j].x + pg8::bf_lo(ow[r][j].x) * rs * gg.x; y.y = xv[r][j].y + pg8::bf_hi(ow[r][j].x) * rs * gg.y; y.z = xv[r][j].z + pg8::bf_lo(ow[r][j].y) * rs * gg.z; y.w = xv[r][j].w + pg8::bf_hi(ow[r][j].y) * rs * gg.w;
                    __builtin_nontemporal_store(y, &yr[64 * j]); } }
        }
    }
#undef GRID_BAR
#undef KA
}

extern "C" void kernel_launch(void* const* d_in, const int* in_sizes, int n_in, void* d_out, int out_size, void* d_ws, size_t ws_size, hipStream_t stream) {
    static int grid = 0;
    if (grid == 0) {
        if (n_in != 19 || in_sizes[0] != MTOK * D || out_size != MTOK * D || ws_size < WS_END) { fprintf(stderr, "kernel_launch: unexpected shapes (n_in %d, in0 %d, out %d, ws %zu); nothing launched\n", n_in, n_in > 0 ? in_sizes[0] : -1, out_size, ws_size); grid = -1; return; }
        int dev = 0, cus = 0, per_cu = 0;
        if (hipGetDevice(&dev) != hipSuccess || hipDeviceGetAttribute(&cus, hipDeviceAttributeMultiprocessorCount, dev) != hipSuccess) { grid = -1; return; }
        if (hipFuncSetAttribute((const void*)hybrid_fwd, hipFuncAttributeMaxDynamicSharedMemorySize, LDS_BYTES) != hipSuccess) { fprintf(stderr, "kernel_launch: hipFuncSetAttribute failed\n"); grid = -1; return; }
        if (hipOccupancyMaxActiveBlocksPerMultiprocessor(&per_cu, (const void*)hybrid_fwd, NWAVES * 64, LDS_BYTES) != hipSuccess || per_cu < 1) { fprintf(stderr, "kernel_launch: occupancy query reports %d\n", per_cu); per_cu = 1; }
        (void)hipGetLastError();
        grid = cus;
    }
    if (grid < 0) return;
    if (hipMemsetAsync((char*)d_ws + WS_CTL, 0, CTL_ZERO_BYTES, stream) != hipSuccess) { fprintf(stderr, "kernel_launch: hipMemsetAsync failed\n"); return; }
    Args a{};
    a.x = (const float*)d_in[0]; a.mem = (const float*)d_in[1]; a.g_pre = (const float*)d_in[2]; a.w_in = (const float*)d_in[3]; a.conv_w = (const float*)d_in[4]; a.conv_b = (const float*)d_in[5];
    a.w_lru_r = (const float*)d_in[6]; a.b_lru_r = (const float*)d_in[7]; a.w_lru_i = (const float*)d_in[8]; a.b_lru_i = (const float*)d_in[9]; a.lru_lambda = (const float*)d_in[10]; a.b_forget = (const float*)d_in[11];
    a.g_mem = (const float*)d_in[12]; a.w_mem_k = (const float*)d_in[13]; a.w_mem_v = (const float*)d_in[14]; a.w_branch = (const float*)d_in[15]; a.b_merge = (const float*)d_in[16]; a.w_out = (const float*)d_in[17]; a.g_post = (const float*)d_in[18];
    a.out = (float*)d_out; a.ws = (unsigned char*)d_ws;
    void* kargs[] = {&a};
    const hipError_t le = hipLaunchCooperativeKernel((const void*)hybrid_fwd, dim3(grid), dim3(NWAVES * 64), kargs, LDS_BYTES, stream);
    if (le != hipSuccess) fprintf(stderr, "kernel_launch: cooperative launch failed: %s (grid %d)\n", hipGetErrorName(le), grid);
}
```

```cpp
#include <hip/hip_runtime.h>
#include <hip/hip_cooperative_groups.h>
#include <hip/hip_bf16.h>
#include <cstdio>
#include <cstdint>
#include <cmath>
namespace cg = cooperative_groups;

constexpr int NB = 8, T = 8192, D = 1024, MTOK = NB * T;
constexpr int CHB = 2, MC = CHB * T, NCHUNK = NB / CHB;
constexpr int IN_COLS = 11280;
constexpr int LDZ = 1024, NZC = 11264, NZT = 44, NIN = 11520;
constexpr size_t ZBLK = (size_t)MC * 1024;
constexpr size_t ZC_AX = 0 * ZBLK, ZC_GA = 1 * ZBLK, ZC_Q = 2 * ZBLK, ZC_K = 3 * ZBLK, ZC_V = 4 * ZBLK, ZC_GF = 5 * ZBLK, ZC_MQ = 6 * ZBLK, ZC_GM = 7 * ZBLK, ZC_MG = 8 * ZBLK;
constexpr int MEMLEN = 256;
constexpr float RMS_EPS = 1e-6f;
constexpr float LOG2E = 1.4426950408889634f;

namespace pg8 {
#define PG8_LAS __attribute__((address_space(3)))
typedef unsigned short bf16_t;
typedef short bf16x8 __attribute__((ext_vector_type(8)));
typedef float f32x4 __attribute__((ext_vector_type(4)));
typedef unsigned u32x4 __attribute__((ext_vector_type(4)));
constexpr int BM = 256, BK = 64, HALF = 128, HTB = HALF * BK * 2, STAGE_BYTES = 8 * HTB, NXCD = 8, WGM = 8;

__host__ __device__ __forceinline__ int lds_byte(int r, int c) { const int st = (r >> 4) * 2 + (c >> 5), rr = r & 15, cc = c & 31, ob = rr * 64 + cc * 2; return st * 1024 + (ob ^ (((ob >> 9) & 1) << 5)); }
__host__ __device__ __forceinline__ void stage_rc(int b, int& R, int& C) { const int st = b / 1024, sb = b % 1024, swz = sb ^ (((sb >> 9) & 1) << 5); R = (st >> 1) * 16 + swz / 64; C = (st & 1) * 32 + (swz % 64) / 2; }
__host__ __device__ __forceinline__ int perm32(int rho) { const int n = rho >> 4, i = rho & 15; return 8 * (i >> 2) + 4 * n + (i & 3); }

struct Unit { int pm, pn, z, ldo; const bf16_t* A; const bf16_t* B; bf16_t* O; const bf16_t* G; };
struct Gemm { int lda, ldb, K; };

struct TileOrder {
    int nM, nN, nwg, G, c;
    __device__ __forceinline__ void init(int nM_, int nN_, int G_, int c_) { nM = nM_; nN = nN_; nwg = nM * nN; G = G_; c = c_; }
    __device__ __forceinline__ bool map(int i, int& pm, int& pn) const {
        const long L = (long)i * G + c; if (L >= nwg) return false;
        int wgid = (int)L; { const int q = nwg / NXCD, r = nwg % NXCD, xcd = wgid % NXCD, off = wgid / NXCD; wgid = (xcd < r ? xcd * (q + 1) : r * (q + 1) + (xcd - r) * q) + off; }
        const int nig = WGM * nN, gid = wgid / nig, fm = gid * WGM, gsz = (nM - fm) < WGM ? (nM - fm) : WGM;
        pm = fm + ((wgid % nig) % gsz); pn = (wgid % nig) / gsz; return true;
    }
};

__device__ __forceinline__ unsigned cvt_pk_bf16(float lo, float hi) { unsigned r; asm volatile("v_cvt_pk_bf16_f32 %0, %1, %2" : "=v"(r) : "v"(lo), "v"(hi)); return r; }
__device__ __forceinline__ float bf_lo(unsigned w) { return __builtin_bit_cast(float, w << 16); }
__device__ __forceinline__ float bf_hi(unsigned w) { return __builtin_bit_cast(float, w & 0xffff0000u); }
__device__ __forceinline__ float sigm(float x) { return __builtin_amdgcn_rcpf(1.f + __expf(-x)); }

template <class Epi, class Sched>
__device__ __forceinline__ void gemm_phase(PG8_LAS unsigned char* lds, const Gemm g, const Sched& S, const Epi& E) {
    int tid_ = threadIdx.x; asm volatile("" : "+v"(tid_));
    const int tid = tid_, wid = __builtin_amdgcn_readfirstlane(tid >> 6), lane = tid & 63, wr = wid >> 2, wc = wid & 3, fr = lane & 15, fq = lane >> 4;
    const int K = g.K, nt = K / BK;
    unsigned voffA[2], voffB[2];
#pragma unroll
    for (int i = 0; i < 2; ++i) { int R, C; stage_rc(tid * 16 + i * 8192, R, C); const int Rb = (R & ~31) + perm32(R & 31);
        voffA[i] = (unsigned)(R * g.lda + C) * 2u; voffB[i] = (unsigned)(Rb * g.ldb + C) * 2u; }
    const size_t kstep = (size_t)(BK * 2);
    const size_t hstepA = (size_t)HALF * g.lda * 2, hstepB = (size_t)HALF * g.ldb * 2;
    const unsigned ldsw = (unsigned)wid * 1024u;
    const int aoff = lds_byte(wr * 64 + fr, fq * 8), boff = lds_byte(wc * 32 + fr, fq * 8);
#define PG8_SA(b, h) (((b) * 2 + (h)) * HTB)
#define PG8_SB(b, h) ((4 + (b) * 2 + (h)) * HTB)
#define PG8_STAGE(bufoff, gbase, voff) do { _Pragma("unroll") for (int _i = 0; _i < 2; ++_i) \
        __builtin_amdgcn_global_load_lds((const unsigned*)((const char*)(gbase) + (voff)[_i]), (PG8_LAS unsigned*)(lds + (bufoff) + ldsw + _i * 8192), 16, 0, 0); } while (0)
#define PG8_LDA(dst, b, h) do { _Pragma("unroll") for (int m = 0; m < 4; ++m) _Pragma("unroll") for (int k = 0; k < 2; ++k) dst[m][k] = *(const PG8_LAS bf16x8*)(lds + PG8_SA(b, h) + aoff + m * 2048 + k * 1024); } while (0)
#define PG8_LDB(dst, b, h) do { _Pragma("unroll") for (int n = 0; n < 2; ++n) _Pragma("unroll") for (int k = 0; k < 2; ++k) dst[n][k] = *(const PG8_LAS bf16x8*)(lds + PG8_SB(b, h) + boff + n * 2048 + k * 1024); } while (0)
#define PG8_MMA(ai, bj, At, Bt) do { __builtin_amdgcn_s_setprio(1); _Pragma("unroll") for (int m = 0; m < 4; ++m) _Pragma("unroll") for (int n = 0; n < 2; ++n) _Pragma("unroll") for (int k = 0; k < 2; ++k) \
        acc[ai][bj][m][n] = __builtin_amdgcn_mfma_f32_16x16x32_bf16(Bt[n][k], At[m][k], acc[ai][bj][m][n], 0, 0, 0); __builtin_amdgcn_s_setprio(0); } while (0)
#define PG8_WAIT_V(n) asm volatile("s_waitcnt vmcnt(" #n ")" ::: "memory")
#define PG8_WAIT_L(n) asm volatile("s_waitcnt lgkmcnt(" #n ")" ::: "memory")
#define PG8_BAR __builtin_amdgcn_s_barrier()
#define PG8_SCHED __builtin_amdgcn_sched_barrier(0)
    Unit cur, nxt; int ui = 0;
    if (!S.next(0, cur)) return;
    f32x4 acc[2][2][4][2];
#pragma unroll
    for (int a = 0; a < 2; ++a)
#pragma unroll
        for (int b = 0; b < 2; ++b)
#pragma unroll
            for (int m = 0; m < 4; ++m)
#pragma unroll
                for (int n = 0; n < 2; ++n) acc[a][b][m][n] = (f32x4){0.f, 0.f, 0.f, 0.f};
    bf16x8 At[4][2], B0[2][2], B1[2][2];
    const char* cA = (const char*)cur.A; const char* cB = (const char*)cur.B;
    PG8_STAGE(PG8_SB(0, 0), cB, voffB); PG8_STAGE(PG8_SB(0, 1), cB + hstepB, voffB); PG8_STAGE(PG8_SA(0, 0), cA, voffA); PG8_STAGE(PG8_SA(0, 1), cA + hstepA, voffA);
    if (wr == 1) PG8_BAR;
    PG8_WAIT_V(2); PG8_BAR;
    PG8_STAGE(PG8_SB(1, 0), cB + kstep, voffB); PG8_STAGE(PG8_SA(1, 0), cA + kstep, voffA); PG8_STAGE(PG8_SB(1, 1), cB + hstepB + kstep, voffB);
    PG8_WAIT_V(6); PG8_BAR;
    for (;;) {
        const bool has_next = S.next(ui + 1, nxt);
        const char* nA = has_next ? (const char*)nxt.A : cA; const char* nB = has_next ? (const char*)nxt.B : cB;
        for (int t = 0; t < nt; t += 2) {
            const bool last = (t == nt - 2);
            const char* a1 = cA + (size_t)(t + 1) * kstep;
            const char* a2 = last ? nA : cA + (size_t)(t + 2) * kstep; const char* b2 = last ? nB : cB + (size_t)(t + 2) * kstep;
            const char* a3 = a2 + kstep; const char* b3 = b2 + kstep;
            PG8_LDB(B0, 0, 0); PG8_LDB(B1, 0, 1); PG8_SCHED; PG8_LDA(At, 0, 0); PG8_STAGE(PG8_SA(1, 1), a1 + hstepA, voffA);
            PG8_WAIT_V(8); PG8_WAIT_L(0); PG8_BAR; PG8_MMA(0, 0, At, B0); PG8_MMA(0, 1, At, B1); PG8_BAR; PG8_SCHED;
            PG8_LDA(At, 0, 1); PG8_STAGE(PG8_SB(0, 0), b2, voffB); PG8_STAGE(PG8_SB(0, 1), b2 + hstepB, voffB); PG8_STAGE(PG8_SA(0, 0), a2, voffA);
            PG8_WAIT_V(8); PG8_WAIT_L(0); PG8_BAR; PG8_MMA(1, 0, At, B0); PG8_MMA(1, 1, At, B1); PG8_BAR; PG8_SCHED;
            PG8_LDB(B0, 1, 0); PG8_LDB(B1, 1, 1); PG8_SCHED; PG8_LDA(At, 1, 0); PG8_STAGE(PG8_SA(0, 1), a2 + hstepA, voffA);
            PG8_WAIT_V(8); PG8_WAIT_L(0); PG8_BAR; PG8_MMA(0, 0, At, B0); PG8_MMA(0, 1, At, B1); PG8_BAR; PG8_SCHED;
            PG8_LDA(At, 1, 1); PG8_STAGE(PG8_SB(1, 0), b3, voffB); PG8_STAGE(PG8_SB(1, 1), b3 + hstepB, voffB); PG8_STAGE(PG8_SA(1, 0), a3, voffA);
            PG8_WAIT_V(8); PG8_WAIT_L(0); PG8_BAR; PG8_MMA(1, 0, At, B0); PG8_MMA(1, 1, At, B1); PG8_BAR; PG8_SCHED;
        }
        if (wr == 0) PG8_BAR;
        E(acc, cur, wr, wc, fr, fq);
        if (!has_next) break;
        if (!(Epi::KEEP && cur.z < 2)) {
#pragma unroll
        for (int a = 0; a < 2; ++a)
#pragma unroll
            for (int b = 0; b < 2; ++b)
#pragma unroll
                for (int m = 0; m < 4; ++m)
#pragma unroll
                    for (int n = 0; n < 2; ++n) acc[a][b][m][n] = (f32x4){0.f, 0.f, 0.f, 0.f};
        }
        cur = nxt; cA = nA; cB = nB; ++ui;
        if (wr == 1) PG8_BAR;
    }
    PG8_WAIT_V(0);
    PG8_BAR;
#undef PG8_SA
#undef PG8_SB
#undef PG8_STAGE
#undef PG8_LDA
#undef PG8_LDB
#undef PG8_MMA
#undef PG8_WAIT_V
#undef PG8_WAIT_L
#undef PG8_SCHED
}

__device__ __forceinline__ float shx(float v, int lane, int m) { return __builtin_bit_cast(float, __builtin_amdgcn_ds_bpermute((lane ^ m) << 2, __builtin_bit_cast(int, v))); }
__device__ __forceinline__ u32x4 pack8(const f32x4 v0, const f32x4 v1) { u32x4 w; w.x = cvt_pk_bf16(v0[0], v0[1]); w.y = cvt_pk_bf16(v0[2], v0[3]); w.z = cvt_pk_bf16(v1[0], v1[1]); w.w = cvt_pk_bf16(v1[2], v1[3]); return w; }
__device__ __forceinline__ void unpack8(const u32x4 w, f32x4& v0, f32x4& v1) { v0[0] = bf_lo(w.x); v0[1] = bf_hi(w.x); v0[2] = bf_lo(w.y); v0[3] = bf_hi(w.y); v1[0] = bf_lo(w.z); v1[1] = bf_hi(w.z); v1[2] = bf_lo(w.w); v1[3] = bf_hi(w.w); }

struct EpiIn {
    static constexpr bool KEEP = false;
    const float* b_merge; int tok0;
    unsigned* NRM;
    __device__ __forceinline__ void operator()(f32x4 (&acc)[2][2][4][2], const Unit& u, int wr, int wc, int fr, int fq) const {
        asm volatile("" : "+v"(fr), "+v"(fq));
        const int lane_ = fq * 16 + fr; (void)lane_;
        const int pn = u.pn;
        {
            const int kind = ((pn >= 4 && pn < 8) || (pn >= 20 && pn < 24) || (pn >= 28 && pn < 32)) ? 1 : (pn >= 8 && pn < 12) ? 2 : (pn >= 32) ? 3 : 0;
            bf16_t* base = u.O + (size_t)(wr * 64 + fr) * LDZ + wc * 32 + 8 * fq;
            f32x4 bv[2][2];
#pragma unroll
            for (int bj = 0; bj < 2; ++bj)
#pragma unroll
                for (int n = 0; n < 2; ++n) bv[bj][n] = (kind == 3) ? *(const f32x4*)(b_merge + (pn * 256 - 8192) + wc * 32 + 8 * fq + bj * HALF + 4 * n) : (f32x4){0.f, 0.f, 0.f, 0.f};
#pragma unroll
            for (int ai = 0; ai < 2; ++ai)
#pragma unroll
                for (int m = 0; m < 4; ++m) { bf16_t* rowp = base + (size_t)(ai * HALF + m * 16) * LDZ;
#pragma unroll
                    for (int bj = 0; bj < 2; ++bj) { f32x4 v0 = acc[ai][bj][m][0], v1 = acc[ai][bj][m][1];
                        if (kind == 1) {
#pragma unroll
                            for (int e = 0; e < 4; ++e) { v0[e] = v0[e] * sigm(v0[e]); v1[e] = v1[e] * sigm(v1[e]); } }
                        else if (kind == 2) { v0 = v0 * (0.125f * LOG2E); v1 = v1 * (0.125f * LOG2E); }
                        else if (kind == 3) {
#pragma unroll
                            for (int e = 0; e < 4; ++e) { v0[e] = sigm(v0[e] + bv[bj][0][e]); v1[e] = sigm(v1[e] + bv[bj][1][e]); } }
                        __builtin_nontemporal_store(pack8(v0, v1), (u32x4*)(rowp + bj * HALF)); } }
            if (pn >= 12 && pn < 16) {
                const float sc2 = (pn < 12) ? (0.125f * LOG2E) * (0.125f * LOG2E) : 1.f;
                const int tokb = tok0 + u.pm * BM, bg = tokb >> 13, qb = (tokb & (T - 1)) >> 8;
#pragma unroll
                for (int bj = 0; bj < 2; ++bj) { float mx = 0.f;
#pragma unroll
                    for (int ai = 0; ai < 2; ++ai)
#pragma unroll
                        for (int m = 0; m < 4; ++m) { const f32x4 v0 = acc[ai][bj][m][0], v1 = acc[ai][bj][m][1];
                            float q = (v0[0] * v0[0] + v0[1] * v0[1]) + (v0[2] * v0[2] + v0[3] * v0[3]) + (v1[0] * v1[0] + v1[1] * v1[1]) + (v1[2] * v1[2] + v1[3] * v1[3]);
                            q += shx(q, lane_, 16); q += shx(q, lane_, 32); mx = fmaxf(mx, q); }
                    mx = fmaxf(mx, shx(mx, lane_, 1)); mx = fmaxf(mx, shx(mx, lane_, 2)); mx = fmaxf(mx, shx(mx, lane_, 4)); mx = fmaxf(mx, shx(mx, lane_, 8));
                    if (lane_ == 0) { const int head = (pn & 3) * 4 + 2 * bj + (wc >> 1), half = wc & 1;
                        unsigned* w = (pn < 12) ? NRM + 1024 + ((bg * 16 + head) * 32 + qb) * 2 + half : NRM + (bg * 16 + head) * 2 + half;
                        __hip_atomic_fetch_max(w, __builtin_bit_cast(unsigned, mx * sc2 * 1.02f), __ATOMIC_RELAXED, __HIP_MEMORY_SCOPE_AGENT); } }
            }
        }
    }
};
struct EpiStore {
    static constexpr bool KEEP = false;
    __device__ __forceinline__ void operator()(f32x4 (&acc)[2][2][4][2], const Unit& u, int wr, int wc, int fr, int fq) const {
        asm volatile("" : "+v"(fr), "+v"(fq));
        const int lane_ = fq * 16 + fr; (void)lane_;
        bf16_t* base = u.O + (size_t)(wr * 64 + fr) * u.ldo + wc * 32 + 8 * fq;
#pragma unroll
        for (int ai = 0; ai < 2; ++ai)
#pragma unroll
            for (int m = 0; m < 4; ++m) { bf16_t* rowp = base + (size_t)(ai * HALF + m * 16) * u.ldo;
#pragma unroll
                for (int bj = 0; bj < 2; ++bj) *(u32x4*)(rowp + bj * HALF) = pack8(acc[ai][bj][m][0], acc[ai][bj][m][1]); }
    }
};
struct EpiSoftmax {
    static constexpr bool KEEP = false;
    PG8_LAS float* xs;
    __device__ __forceinline__ void operator()(f32x4 (&acc)[2][2][4][2], const Unit& u, int wr, int wc, int fr, int fq) const {
        asm volatile("" : "+v"(fr), "+v"(fq));
        const int lane_ = fq * 16 + fr; (void)lane_;
        const float sc = 0.0625f * LOG2E;
        float lm[2][4];
#pragma unroll
        for (int ai = 0; ai < 2; ++ai)
#pragma unroll
            for (int m = 0; m < 4; ++m) {
                float mx = -INFINITY;
#pragma unroll
                for (int bj = 0; bj < 2; ++bj)
#pragma unroll
                    for (int n = 0; n < 2; ++n)
#pragma unroll
                        for (int e = 0; e < 4; ++e) mx = fmaxf(mx, acc[ai][bj][m][n][e]);
                mx = fmaxf(mx, shx(mx, lane_, 16)); mx = fmaxf(mx, shx(mx, lane_, 32)); mx *= sc;
                float s = 0.f;
#pragma unroll
                for (int bj = 0; bj < 2; ++bj)
#pragma unroll
                    for (int n = 0; n < 2; ++n)
#pragma unroll
                        for (int e = 0; e < 4; ++e) { const float p = __builtin_amdgcn_exp2f(acc[ai][bj][m][n][e] * sc - mx); acc[ai][bj][m][n][e] = p; s += p; }
                s += shx(s, lane_, 16); s += shx(s, lane_, 32);
                lm[ai][m] = mx;
                if (fq == 0) { const int row = ai * HALF + wr * 64 + m * 16 + fr; xs[(row * 4 + wc) * 2] = mx; xs[(row * 4 + wc) * 2 + 1] = s; }
            }
        asm volatile("s_waitcnt lgkmcnt(0)" ::: "memory"); PG8_BAR; asm volatile("" ::: "memory");
        bf16_t* base = u.O + (size_t)(wr * 64 + fr) * u.ldo + wc * 32 + 8 * fq;
#pragma unroll
        for (int ai = 0; ai < 2; ++ai)
#pragma unroll
            for (int m = 0; m < 4; ++m) { const int row = ai * HALF + wr * 64 + m * 16 + fr;
                const f32x4 a = *(const PG8_LAS f32x4*)(xs + row * 8), b = *(const PG8_LAS f32x4*)(xs + row * 8 + 4);
                const float M = fmaxf(fmaxf(a[0], a[2]), fmaxf(b[0], b[2]));
                const float tot = a[1] * __builtin_amdgcn_exp2f(a[0] - M) + a[3] * __builtin_amdgcn_exp2f(a[2] - M) + b[1] * __builtin_amdgcn_exp2f(b[0] - M) + b[3] * __builtin_amdgcn_exp2f(b[2] - M);
                const float f = __builtin_amdgcn_exp2f(lm[ai][m] - M) * __builtin_amdgcn_rcpf(tot);
                bf16_t* rowp = base + (size_t)(ai * HALF + m * 16) * u.ldo;
#pragma unroll
                for (int bj = 0; bj < 2; ++bj) *(u32x4*)(rowp + bj * HALF) = pack8(acc[ai][bj][m][0] * f, acc[ai][bj][m][1] * f); }
    }
};
struct EpiMul {
    static constexpr bool KEEP = false;
    __device__ __forceinline__ void operator()(f32x4 (&acc)[2][2][4][2], const Unit& u, int wr, int wc, int fr, int fq) const {
        asm volatile("" : "+v"(fr), "+v"(fq));
        const size_t lo = (size_t)(wr * 64 + fr) * LDZ + wc * 32 + 8 * fq;
#pragma unroll
        for (int ai = 0; ai < 2; ++ai) {
            u32x4 gw[4][2];
#pragma unroll
            for (int m = 0; m < 4; ++m)
#pragma unroll
                for (int bj = 0; bj < 2; ++bj) gw[m][bj] = *(const u32x4*)(u.G + lo + (size_t)(ai * HALF + m * 16) * LDZ + bj * HALF);
#pragma unroll
            for (int m = 0; m < 4; ++m)
#pragma unroll
                for (int bj = 0; bj < 2; ++bj) { f32x4 g0, g1; unpack8(gw[m][bj], g0, g1);
                    *(u32x4*)(u.O + lo + (size_t)(ai * HALF + m * 16) * LDZ + bj * HALF) = pack8(acc[ai][bj][m][0] * g0, acc[ai][bj][m][1] * g1); }
        }
    }
};
struct EpiMerge {
    static constexpr bool KEEP = true;
    __device__ __forceinline__ void operator()(f32x4 (&acc)[2][2][4][2], const Unit& u, int wr, int wc, int fr, int fq) const {
        asm volatile("" : "+v"(fr), "+v"(fq));
        const size_t lg = (size_t)(wr * 64 + fr) * LDZ + wc * 32 + 8 * fq, lo = (size_t)(wr * 64 + fr) * u.ldo + wc * 32 + 8 * fq;
        const bool last = (u.z == 2);
#pragma unroll
        for (int ai = 0; ai < 2; ++ai) {
            u32x4 gw[4][2], hw[4][2];
#pragma unroll
            for (int m = 0; m < 4; ++m)
#pragma unroll
                for (int bj = 0; bj < 2; ++bj) { const bf16_t* gp = u.G + lg + (size_t)(ai * HALF + m * 16) * LDZ + bj * HALF; gw[m][bj] = *(const u32x4*)gp;
                    hw[m][bj] = (u32x4){0u, 0u, 0u, 0u}; if (!last) hw[m][bj] = *(const u32x4*)(gp + ZBLK); }
#pragma unroll
            for (int m = 0; m < 4; ++m)
#pragma unroll
                for (int bj = 0; bj < 2; ++bj) { f32x4 g0, g1; unpack8(gw[m][bj], g0, g1);
                    if (last) { *(u32x4*)(u.O + lo + (size_t)(ai * HALF + m * 16) * u.ldo + bj * HALF) = pack8(acc[ai][bj][m][0] * g0, acc[ai][bj][m][1] * g1); }
                    else { f32x4 h0, h1; unpack8(hw[m][bj], h0, h1);
#pragma unroll
                        for (int e = 0; e < 4; ++e) { acc[ai][bj][m][0][e] *= g0[e] * __builtin_amdgcn_rcpf(fmaxf(h0[e], 1e-20f)); acc[ai][bj][m][1][e] *= g1[e] * __builtin_amdgcn_rcpf(fmaxf(h1[e], 1e-20f)); } } }
        }
    }
};
struct EpiOut {
    static constexpr bool KEEP = false;
    float* SSP;
    __device__ __forceinline__ void operator()(f32x4 (&acc)[2][2][4][2], const Unit& u, int wr, int wc, int fr, int fq) const {
        asm volatile("" : "+v"(fr), "+v"(fq));
        const int lane_ = fq * 16 + fr; (void)lane_;
        bf16_t* base = u.O + (size_t)(wr * 64 + fr) * u.ldo + wc * 32 + 8 * fq;
#pragma unroll
        for (int ai = 0; ai < 2; ++ai)
#pragma unroll
            for (int m = 0; m < 4; ++m) { bf16_t* rowp = base + (size_t)(ai * HALF + m * 16) * u.ldo; float s = 0.f;
#pragma unroll
                for (int bj = 0; bj < 2; ++bj) { const f32x4 v0 = acc[ai][bj][m][0], v1 = acc[ai][bj][m][1];
                    s += (v0[0] * v0[0] + v0[1] * v0[1]) + (v0[2] * v0[2] + v0[3] * v0[3]) + (v1[0] * v1[0] + v1[1] * v1[1]) + (v1[2] * v1[2] + v1[3] * v1[3]);
                    __builtin_nontemporal_store(pack8(v0, v1), (u32x4*)(rowp + bj * HALF)); }
                s += shx(s, lane_, 16); s += shx(s, lane_, 32);
                if (fq == 0) SSP[(size_t)(u.z + ai * HALF + wr * 64 + m * 16 + fr) * 16 + u.pn * 4 + wc] = s; }
    }
};
#undef PG8_BAR
}

namespace attn_body {
using bf16=__hip_bfloat16;
using bf16x8=__attribute__((ext_vector_type(8)))short;
using s16x4=__attribute__((ext_vector_type(4)))short;
using f32x16=__attribute__((ext_vector_type(16)))float;
using f32x4=__attribute__((ext_vector_type(4)))float;
using u32x4=__attribute__((ext_vector_type(4)))unsigned;
constexpr int BATCH=CHB,NHEAD=16,SEQ=T,D=64,DM=LDZ;
constexpr int NW=8,QBLK=32,QB=QBLK*NW,KVBLK=64,NQB=SEQ/QB;
__device__ __forceinline__ int crow(int r,int hi){return (r&3)+8*(r>>2)+4*hi;}
#define SBAR() __builtin_amdgcn_sched_barrier(0)
__device__ __forceinline__ void cmask(f32x16&p0,f32x16&p1,int jb,int qrel,int hi){
  const float NEG=-INFINITY; int kb=64*jb+4*hi;
  #pragma unroll
  for(int r=0;r<16;++r){int kv=kb+(r&3)+8*(r>>2); if(kv>qrel)p0[r]=NEG; if(kv+32>qrel)p1[r]=NEG;}
}
constexpr int NSLOT=3, SLOTB=8192;
constexpr int LDS_K=0, LDS_V=NSLOT*SLOTB, LDS_WS=2*NSLOT*SLOTB, LDS_OST=LDS_WS+NW*64*4, LDS_BIAS=LDS_OST+NW*4096, LDS_BYTES=LDS_BIAS+SEQ*4;
__device__ __forceinline__ void glds16(const void*gsrc,unsigned lds_dst){unsigned keep;
  asm volatile("s_mov_b32 %0, m0\n\ts_mov_b32 m0, %2\n\ts_nop 0\n\tglobal_load_lds_dwordx4 %1, off\n\ts_mov_b32 m0, %0":"=&s"(keep):"v"(gsrc),"s"(lds_dst):"memory");}
__device__ __forceinline__ float max3f(float a,float b,float c){float r;asm("v_max3_f32 %0, %1, %2, %3":"=v"(r):"v"(a),"v"(b),"v"(c));return r;}
__device__ __forceinline__ float max2f(float a,float b){float r;asm("v_max_f32_e32 %0, %1, %2":"=v"(r):"v"(a),"v"(b));return r;}
__device__ __forceinline__ float fadd_s(float a,float b){float r;asm("v_add_f32_e32 %0, %1, %2":"=v"(r):"v"(a),"v"(b));return r;}
__device__ __forceinline__ float fsub_s(float a,float b){float r;asm("v_sub_f32_e32 %0, %1, %2":"=v"(r):"v"(a),"v"(b));return r;}
typedef float f32x2_t __attribute__((ext_vector_type(2))); typedef __bf16 bf16x2_t __attribute__((ext_vector_type(2)));
__device__ __forceinline__ unsigned cvtpk_s(float lo,float hi){f32x2_t v={lo,hi};bf16x2_t b=__builtin_convertvector(v,bf16x2_t);return __builtin_bit_cast(unsigned,b);}
#define WAIT_BAR(N) asm volatile("s_waitcnt vmcnt(" #N ") lgkmcnt(0)\n\ts_barrier":::"memory")
typedef __attribute__((address_space(3))) const char* lds_cptr;
typedef short v4i16_t __attribute__((ext_vector_type(4)));
__device__ __forceinline__ void cinit(f32x16&c0,f32x16&c1,lds_cptr bp,int hi,float negmh){
  #pragma unroll
  for(int g=0;g<4;++g){
    const f32x4 b0=*(const __attribute__((address_space(3))) f32x4*)(bp+(8*g+4*hi)*4);
    const f32x4 b1=*(const __attribute__((address_space(3))) f32x4*)(bp+(32+8*g+4*hi)*4);
    #pragma unroll
    for(int e=0;e<4;++e){c0[4*g+e]=b0[e]+negmh;c1[4*g+e]=b1[e]+negmh;}}
}
__device__ __forceinline__ void qkt(f32x16&p0,f32x16&p1,const char*Kslot,const bf16x8*qr,int r32,int hi){
  const char*kb=Kslot+hi*1024+r32*16;
  #pragma unroll
  for(int d0=0;d0<4;++d0){
    const bf16x8 b0=*reinterpret_cast<const bf16x8*>(kb+d0*2048);
    const bf16x8 b1=*reinterpret_cast<const bf16x8*>(kb+d0*2048+512);
    p0=__builtin_amdgcn_mfma_f32_32x32x16_bf16(b0,qr[d0],p0,0,0,0);p1=__builtin_amdgcn_mfma_f32_32x32x16_bf16(b1,qr[d0],p1,0,0,0);}
}
__device__ __forceinline__ void kload8(bf16x8*kf,lds_cptr kp){
  kf[0]=*(const __attribute__((address_space(3))) bf16x8*)(kp);      kf[1]=*(const __attribute__((address_space(3))) bf16x8*)(kp+512);
  kf[2]=*(const __attribute__((address_space(3))) bf16x8*)(kp+2048); kf[3]=*(const __attribute__((address_space(3))) bf16x8*)(kp+2560);
  kf[4]=*(const __attribute__((address_space(3))) bf16x8*)(kp+4096); kf[5]=*(const __attribute__((address_space(3))) bf16x8*)(kp+4608);
  kf[6]=*(const __attribute__((address_space(3))) bf16x8*)(kp+6144); kf[7]=*(const __attribute__((address_space(3))) bf16x8*)(kp+6656);
}
__device__ __forceinline__ void kload2(bf16x8*kf,lds_cptr kp,int j){ kf[2*j]=*(const __attribute__((address_space(3))) bf16x8*)(kp+j*2048); kf[2*j+1]=*(const __attribute__((address_space(3))) bf16x8*)(kp+j*2048+512); }
__device__ __forceinline__ s16x4 vtr(lds_cptr p){ return __builtin_bit_cast(s16x4,__builtin_amdgcn_ds_read_tr16_b64_v4i16((__attribute__((address_space(3))) v4i16_t*)p)); }
__device__ __forceinline__ float rowmax(const f32x16&p0,const f32x16&p1){
  float a=max3f(p0[0],p0[1],p1[0]),b=max3f(p0[2],p0[3],p1[1]);a=max3f(a,p1[2],p1[3]);
  #pragma unroll
  for(int r=4;r<16;r+=4){a=max3f(a,p0[r],p0[r+1]);b=max3f(b,p0[r+2],p0[r+3]);a=max3f(a,p1[r],p1[r+1]);b=max3f(b,p1[r+2],p1[r+3]);}
  const float m=max2f(a,b);
  auto rr=__builtin_amdgcn_permlane32_swap(__float_as_uint(m),__float_as_uint(m),false,false);
  return max2f(__uint_as_float(rr[0]),__uint_as_float(rr[1]));
}
__device__ __forceinline__ void pv(f32x16*o,int vb,bf16x8 pa0,bf16x8 pa1,bf16x8 pa2,bf16x8 pa3){
  #pragma unroll
  for(int d0=0;d0<2;++d0){s16x4 lo[4],hi[4];
    #pragma unroll
    for(int ks=0;ks<4;++ks){
      asm volatile("ds_read_b64_tr_b16 %0,%1 offset:%c2":"=&v"(lo[ks]):"v"(vb),"i"(d0*4096+ks*1024):"memory");
      asm volatile("ds_read_b64_tr_b16 %0,%1 offset:%c2":"=&v"(hi[ks]):"v"(vb),"i"(d0*4096+ks*1024+512):"memory");}
    asm volatile("s_waitcnt lgkmcnt(0)":::"memory");SBAR();
    #define PK(k) (bf16x8){lo[k][0],lo[k][1],lo[k][2],lo[k][3],hi[k][0],hi[k][1],hi[k][2],hi[k][3]}
    o[d0]=__builtin_amdgcn_mfma_f32_32x32x16_bf16(pa0,PK(0),o[d0],0,0,0);
    o[d0]=__builtin_amdgcn_mfma_f32_32x32x16_bf16(pa1,PK(1),o[d0],0,0,0);
    o[d0]=__builtin_amdgcn_mfma_f32_32x32x16_bf16(pa2,PK(2),o[d0],0,0,0);
    o[d0]=__builtin_amdgcn_mfma_f32_32x32x16_bf16(pa3,PK(3),o[d0],0,0,0);
    #undef PK
  }
}
__device__ __forceinline__ u32x4 mul_bf16x8(u32x4 a,u32x4 b){
  u32x4 r;
  r.x=cvtpk_s(pg8::bf_lo(a.x)*pg8::bf_lo(b.x),pg8::bf_hi(a.x)*pg8::bf_hi(b.x)); r.y=cvtpk_s(pg8::bf_lo(a.y)*pg8::bf_lo(b.y),pg8::bf_hi(a.y)*pg8::bf_hi(b.y));
  r.z=cvtpk_s(pg8::bf_lo(a.z)*pg8::bf_lo(b.z),pg8::bf_hi(a.z)*pg8::bf_hi(b.z)); r.w=cvtpk_s(pg8::bf_lo(a.w)*pg8::bf_lo(b.w),pg8::bf_hi(a.w)*pg8::bf_hi(b.w));
  return r;
}

template<int THRL> __device__ __forceinline__ void attn_unit(int b,int h,int qb,const bf16*Q,const bf16*__restrict__ K,const bf16*__restrict__ V,bf16*O,const bf16*GF,const float*CBh,const unsigned*KN,const unsigned*QN,char*shm){
  int tid_=threadIdx.x; asm volatile("":"+v"(tid_));
  const int tid=tid_,lane=tid&63,r32=lane&31,hi=lane>>5; const int wid=__builtin_amdgcn_readfirstlane(tid>>6);
  const long rowbase=(long)b*SEQ; const int q0=qb*QB;
  const bf16*Qw=Q+(rowbase+q0+wid*QBLK)*DM+h*D;
  { const int n4=(q0+QB)>>2; f32x4*dst=(f32x4*)(shm+LDS_BIAS); const f32x4*src=(const f32x4*)CBh;
    for(int i=tid;i<n4;i+=NW*64)dst[i]=src[i]; }
  bf16x8 qr[4];
  #pragma unroll
  for(int d0=0;d0<4;++d0)qr[d0]=*reinterpret_cast<const bf16x8*>(&Qw[(long)r32*DM+d0*16+hi*8]);
  float umin;
  { const bf16*Kd=K+(rowbase+q0+wid*QBLK)*DM+h*D; float ds=0.f,qq=0.f;
    #pragma unroll
    for(int d0=0;d0<4;++d0){ const bf16x8 kk=*reinterpret_cast<const bf16x8*>(&Kd[(long)r32*DM+d0*16+hi*8]);
      #pragma unroll
      for(int e=0;e<8;++e){ const float qf=__builtin_bit_cast(float,(unsigned)(unsigned short)qr[d0][e]<<16); ds+=qf*__builtin_bit_cast(float,(unsigned)(unsigned short)kk[e]<<16); qq+=qf*qf; } }
    { auto rr=__builtin_amdgcn_permlane32_swap(__float_as_uint(ds),__float_as_uint(ds),false,false); ds=__uint_as_float(rr[0])+__uint_as_float(rr[1]); }
    { auto rr=__builtin_amdgcn_permlane32_swap(__float_as_uint(qq),__float_as_uint(qq),false,false); qq=__uint_as_float(rr[0])+__uint_as_float(rr[1]); }
    const float kmx=sqrtf(__uint_as_float(KN[0])+__uint_as_float(KN[1]));
    float v=ds+CBh[q0+wid*QBLK+r32]-sqrtf(qq)*kmx*1.001f;
    #pragma unroll
    for(int m=1;m<32;m<<=1)v=fminf(v,__builtin_bit_cast(float,__builtin_amdgcn_ds_bpermute((lane^m)<<2,__builtin_bit_cast(int,v))));
    float*wmin=(float*)(shm+LDS_WS);
    if(lane==0)wmin[wid*64]=v;
    asm volatile("s_waitcnt lgkmcnt(0)\n\ts_barrier":::"memory");
    umin=wmin[0];
    #pragma unroll
    for(int w_=1;w_<NW;++w_)umin=fminf(umin,wmin[w_*64]); }
  int t0=0;
  { const float cutoff=umin-0.01f-38.f;     const int ntm4=(q0+QB)/KVBLK-4; int cnt=0;
    for(int base=0;base<ntm4;base+=64){ const int tt=base+lane; const bool skip=(tt<ntm4)&&(CBh[64*tt+63]<cutoff); cnt+=__popcll(__ballot(skip)); }
    t0=__builtin_amdgcn_readfirstlane(cnt)&~1; }
  const bf16*Kh=K+(rowbase+(long)t0*KVBLK)*DM+h*D,*Vh=V+(rowbase+(long)t0*KVBLK)*DM+h*D;
  const unsigned lds0=(unsigned)(uintptr_t)shm;
  float*wsf=(float*)(shm+LDS_WS)+wid*64;
  asm volatile("s_waitcnt vmcnt(0)":::"memory");
  const bf16*ksrc=Kh+(long)lane*DM+wid*8;
  const bf16*vsrc=Vh+(long)(16*(wid&3)+(lane>>2))*DM+(wid>>2)*32+(lane&3)*8;
  const unsigned kdst=lds0+LDS_K+wid*1024, vdst=lds0+LDS_V+wid*1024;
  #define DMA_K(t,slot) glds16(ksrc+(long)(t)*KVBLK*DM,(unsigned)__builtin_amdgcn_readfirstlane(kdst+(slot)))
  #define DMA_V(t,slot) glds16(vsrc+(long)(t)*KVBLK*DM,(unsigned)__builtin_amdgcn_readfirstlane(vdst+(slot)))
  const int vb0=(int)(lds0+LDS_V)+((lane>>4)&1)*32+(lane&3)*8+(4*hi+((lane&15)>>2))*64;
  const char*Kbase=shm+LDS_K; bf16x8 kf[8];
  const lds_cptr shm3=(lds_cptr)shm; const lds_cptr kp0=shm3+LDS_K+hi*1024+r32*16; const lds_cptr vp0=shm3+LDS_V+((lane>>4)&1)*32+(lane&3)*8+(4*hi+((lane&15)>>2))*64;
  const lds_cptr bias0=shm3+LDS_BIAS+t0*256;
  const int NT=(q0+QB)/KVBLK-t0;
  DMA_K(0,0);DMA_V(0,0);DMA_K(1,SLOTB);
  float mhat=0.f,l_reg=0.f;f32x16 o[2];o[0]=f32x16{};o[1]=f32x16{};
  const int qrel=wid*QBLK+r32;
  #define CMASK(P0,P1,t) do{int jb_=(t)-(NT-4); if(jb_>=0)cmask(P0,P1,jb_,qrel,hi);}while(0)
  bool resc=false;
  #define START(P0,P1) do{ const float rm=rowmax(P0,P1); resc=false; \
    { const float dl=rm; mhat=fadd_s(mhat,dl); \
      _Pragma("unroll") for(int r=0;r<16;++r){P0[r]=fsub_s(P0[r],dl);P1[r]=fsub_s(P1[r],dl);} } \
    _Pragma("unroll") for(int r=0;r<16;++r)P0[r]=__builtin_amdgcn_exp2f(P0[r]); }while(0)
  #define RESC() do{ if(resc){ asm volatile("s_waitcnt lgkmcnt(0)":::"memory"); \
      _Pragma("unroll") for(int d_=0;d_<2;++d_) _Pragma("unroll") for(int r=0;r<16;++r)o[d_][r]*=wsf[crow(r,hi)]; } }while(0)
  f32x16 pA0,pA1,pB0,pB1;
  int sl_prev=0,sl_cur=0,sl_next=SLOTB;
  #define ROT() do{sl_prev=sl_cur;sl_cur=sl_next;sl_next=(sl_next==(NSLOT-1)*SLOTB)?0:sl_next+SLOTB;}while(0)
  DMA_K(2,2*SLOTB);
  WAIT_BAR(3);
  cinit(pA0,pA1,bias0,hi,0.f);
  qkt(pA0,pA1,Kbase,qr,r32,hi);asm volatile("s_nop 15\n\ts_nop 7":"+v"(pA0),"+v"(pA1));CMASK(pA0,pA1,0);
  START(pA0,pA1);
  _Pragma("unroll") for(int r=0;r<16;++r)pA1[r]=__builtin_amdgcn_exp2f(pA1[r]);
  WAIT_BAR(0);
  DMA_K(3,0);DMA_V(1,SLOTB);
  ROT();
  kload8(kf,kp0+sl_cur);
  WAIT_BAR(2);
  s16x4 vlo[8],vhi[8]; u32x4 pw0,pw1,pw2,pw3;
  #define PKW(P,B) cvtpk_s(P[B],P[B+1])
  #define PAF(k) __builtin_bit_cast(bf16x8,pw##k)
  #define VFR(i) (bf16x8){vlo[i][0],vlo[i][1],vlo[i][2],vlo[i][3],vhi[i][0],vhi[i][1],vhi[i][2],vhi[i][3]}
  #define PIN(x) asm volatile("":"+v"(x))
  #define MX3(a,b,c) __builtin_fmaxf(__builtin_fmaxf((a),(b)),(c))
  #define GAPA(MF,A0,A1,A2,A3,W0,W1,PW) do{ MF; sacc+=A0; sacc+=A1; sacc+=A2; sacc+=A3; PIN(sacc); W0; W1; PIN(PW); SBAR(); }while(0)
  #define EX(v) __builtin_amdgcn_exp2f(v)
  #define GAPB(MF,X,B) do{ MF; X[B]=EX(X[B]); X[B+1]=EX(X[B+1]); X[B+2]=EX(X[B+2]); X[B+3]=EX(X[B+3]); PIN(X); SBAR(); }while(0)
  #define VRD(i) do{ vlo[i]=vtr(vp_+(((i)>>2)*4096+((i)&3)*1024)); vhi[i]=vtr(vp_+(((i)>>2)*4096+((i)&3)*1024+512)); }while(0)
  #define KRD(G,j) do{ if(G){ kload2(kf,kp0+sl_next,j); SBAR(); } }while(0)
  #define STEP(C0,C1,P0,P1,t,GK,GV,GL) do{ SBAR(); \
    const lds_cptr vp_=vp0+sl_prev; \
    cinit(C0,C1,bias0+(t)*256,hi,-mhat); SBAR(); \
    VRD(0); SBAR(); float sacc=(P0[0]+P0[1]); \
    GAPA(C0=__builtin_amdgcn_mfma_f32_32x32x16_bf16(kf[0],qr[0],C0,0,0,0), P0[2],P0[3],P0[4],P0[5],     pw0[0]=PKW(P0,0), pw0[1]=PKW(P0,2), pw0); \
    VRD(4); SBAR(); GAPA(C1=__builtin_amdgcn_mfma_f32_32x32x16_bf16(kf[1],qr[0],C1,0,0,0), P0[6],P0[7],P0[8],P0[9],     pw0[2]=PKW(P0,4), pw0[3]=PKW(P0,6), pw0); \
    VRD(1); SBAR(); GAPA(C0=__builtin_amdgcn_mfma_f32_32x32x16_bf16(kf[2],qr[1],C0,0,0,0),   P0[10],P0[11],P0[12],P0[13], pw1[0]=PKW(P0,8), pw1[1]=PKW(P0,10), pw1); \
    VRD(5); SBAR(); GAPA(C1=__builtin_amdgcn_mfma_f32_32x32x16_bf16(kf[3],qr[1],C1,0,0,0),   P0[14],P0[15],P1[0],P1[1],   pw1[2]=PKW(P0,12),pw1[3]=PKW(P0,14), pw1); \
    VRD(2); SBAR(); GAPA(C0=__builtin_amdgcn_mfma_f32_32x32x16_bf16(kf[4],qr[2],C0,0,0,0),   P1[2],P1[3],P1[4],P1[5],     pw2[0]=PKW(P1,0), pw2[1]=PKW(P1,2), pw2); \
    VRD(6); SBAR(); GAPA(C1=__builtin_amdgcn_mfma_f32_32x32x16_bf16(kf[5],qr[2],C1,0,0,0),   P1[6],P1[7],P1[8],P1[9],     pw2[2]=PKW(P1,4), pw2[3]=PKW(P1,6), pw2); \
    VRD(3); SBAR(); GAPA(C0=__builtin_amdgcn_mfma_f32_32x32x16_bf16(kf[6],qr[3],C0,0,0,0),   P1[10],P1[11],P1[12],P1[13], pw3[0]=PKW(P1,8), pw3[1]=PKW(P1,10), pw3); \
    VRD(7); SBAR(); GAPA(C1=__builtin_amdgcn_mfma_f32_32x32x16_bf16(kf[7],qr[3],C1,0,0,0),   P1[14],P1[15],0.f,0.f,       pw3[2]=PKW(P1,12),pw3[3]=PKW(P1,14), pw3); \
    l_reg+=sacc; \
    if(GK){DMA_K((t)+3,sl_cur);} if(GV){DMA_V((t)+1,sl_next);} \
    CMASK(C0,C1,t); \
    { float a=MX3(C0[0],C0[1],C1[0]),b=MX3(C0[2],C0[3],C1[1]); a=MX3(a,C1[2],C1[3]); \
      _Pragma("unroll") for(int r=4;r<16;r+=4){a=MX3(a,C0[r],C0[r+1]);b=MX3(b,C0[r+2],C0[r+3]);a=MX3(a,C1[r],C1[r+1]);b=MX3(b,C1[r+2],C1[r+3]);} \
      float rm=__builtin_fmaxf(a,b); { auto rr=__builtin_amdgcn_permlane32_swap(__float_as_uint(rm),__float_as_uint(rm),false,false); rm=__builtin_fmaxf(__uint_as_float(rr[0]),__uint_as_float(rr[1])); } \
      resc=false; \
      if(__builtin_expect(__any(rm>(float)THRL),0)){ const float dl=__builtin_fmaxf(rm,0.f); mhat+=dl; \
        _Pragma("unroll") for(int r=0;r<16;++r){C0[r]-=dl;C1[r]-=dl;} \
        const float f=__builtin_amdgcn_exp2f(-dl); l_reg*=f; if(hi==0)wsf[r32]=f; resc=true; } } \
    SBAR(); \
    GAPB(o[0]=__builtin_amdgcn_mfma_f32_32x32x16_bf16(PAF(0),VFR(0),o[0],0,0,0), C0,0); \
    GAPB(o[1]=__builtin_amdgcn_mfma_f32_32x32x16_bf16(PAF(0),VFR(4),o[1],0,0,0), C0,4); \
    KRD(GL,0); GAPB(o[0]=__builtin_amdgcn_mfma_f32_32x32x16_bf16(PAF(1),VFR(1),o[0],0,0,0), C0,8); \
    KRD(GL,1); GAPB(o[1]=__builtin_amdgcn_mfma_f32_32x32x16_bf16(PAF(1),VFR(5),o[1],0,0,0), C0,12); \
    KRD(GL,2); GAPB(o[0]=__builtin_amdgcn_mfma_f32_32x32x16_bf16(PAF(2),VFR(2),o[0],0,0,0), C1,0); \
    KRD(GL,3); GAPB(o[1]=__builtin_amdgcn_mfma_f32_32x32x16_bf16(PAF(2),VFR(6),o[1],0,0,0), C1,4); \
    GAPB(o[0]=__builtin_amdgcn_mfma_f32_32x32x16_bf16(PAF(3),VFR(3),o[0],0,0,0), C1,8); \
    GAPB(o[1]=__builtin_amdgcn_mfma_f32_32x32x16_bf16(PAF(3),VFR(7),o[1],0,0,0), C1,12); \
    }while(0)
  int t=1;
  #undef CMASK
  #define CMASK(P0,P1,t) do{}while(0)
  for(;t+5<NT;t+=2){
    STEP(pB0,pB1,pA0,pA1,t,true,true,true);     WAIT_BAR(2); RESC(); ROT();
    STEP(pA0,pA1,pB0,pB1,t+1,true,true,true);   WAIT_BAR(2); RESC(); ROT();
  }
  #undef CMASK
  #define CMASK(P0,P1,t) do{int jb_=(t)-(NT-4); if(jb_>=0)cmask(P0,P1,jb_,qrel,hi);}while(0)
  #define ENDW(tt) do{ if((tt)+3<NT){WAIT_BAR(2);} else if((tt)+2<NT){WAIT_BAR(1);} else {WAIT_BAR(0);} }while(0)
  for(;t+1<NT;t+=2){
    STEP(pB0,pB1,pA0,pA1,t,(t+3<NT),(t+1<NT),(t+1<NT));       ENDW(t);   RESC(); ROT();
    STEP(pA0,pA1,pB0,pB1,t+1,(t+4<NT),(t+2<NT),(t+2<NT));     ENDW(t+1); RESC(); ROT();
  }
  STEP(pB0,pB1,pA0,pA1,NT-1,false,false,false); RESC();
  { float sacc=pB0[0]+pB0[1]; _Pragma("unroll") for(int r=2;r<16;++r)sacc+=pB0[r]; _Pragma("unroll") for(int r=0;r<16;++r)sacc+=pB1[r]; l_reg+=sacc;
    pw0=(u32x4){PKW(pB0,0),PKW(pB0,2),PKW(pB0,4),PKW(pB0,6)};pw1=(u32x4){PKW(pB0,8),PKW(pB0,10),PKW(pB0,12),PKW(pB0,14)};pw2=(u32x4){PKW(pB1,0),PKW(pB1,2),PKW(pB1,4),PKW(pB1,6)};pw3=(u32x4){PKW(pB1,8),PKW(pB1,10),PKW(pB1,12),PKW(pB1,14)};
    SBAR(); pv(o,vb0+sl_cur,PAF(0),PAF(1),PAF(2),PAF(3)); }
  #undef PKW
  #undef PAF
  #undef VFR
  #undef PIN
  #undef MX3
  #undef GAPA
  #undef GAPB
  #undef EX
  #undef VRD
  #undef KRD
  #undef STEP
  #undef ENDW
  {auto rr=__builtin_amdgcn_permlane32_swap(__float_as_uint(l_reg),__float_as_uint(l_reg),false,false);l_reg=__uint_as_float(rr[0])+__uint_as_float(rr[1]);}
  if(hi==0)wsf[32+r32]=l_reg;asm volatile("s_waitcnt lgkmcnt(0)":::"memory");
  float rli[16];
  #pragma unroll
  for(int r=0;r<16;++r)rli[r]=__builtin_amdgcn_rcpf(wsf[32+crow(r,hi)]);
  bf16*Ow=O+(rowbase+q0+wid*QBLK)*DM+h*D;
  const bf16*Gw=GF+(rowbase+q0+wid*QBLK)*DM+h*D;
  { bf16*stg=(bf16*)(shm+LDS_OST)+wid*2048;
    #pragma unroll
    for(int r=0;r<16;++r){const int orow=crow(r,hi);
      #pragma unroll
      for(int d0=0;d0<2;++d0)stg[orow*64+d0*32+r32]=__float2bfloat16(o[d0][r]*rli[r]);}
    asm volatile("s_waitcnt lgkmcnt(0)":::"memory");
    u32x4 gg[4];
    #pragma unroll
    for(int i=0;i<4;++i){const int row=i*8+(lane>>3),ch=lane&7; gg[i]=*(const u32x4*)(Gw+(long)row*DM+ch*8);}
    #pragma unroll
    for(int i=0;i<4;++i){const int row=i*8+(lane>>3),ch=lane&7; const u32x4 v=*(const u32x4*)(stg+row*64+ch*8);
      *(u32x4*)(Ow+(long)row*DM+ch*8)=mul_bf16x8(v,gg[i]);} }
  asm volatile("s_waitcnt vmcnt(0) lgkmcnt(0)\n\ts_barrier":::"memory");
  #undef DMA_K
  #undef DMA_V
  #undef CMASK
  #undef START
  #undef RESC
  #undef ROT
}
constexpr int ATTN_LDS_BYTES=LDS_BYTES;
#undef SBAR
#undef WAIT_BAR
}

constexpr int NWAVES = 8;
constexpr size_t MiB = 1u << 20;
constexpr size_t WS_CTL = 0, CTL_ZERO_BYTES = 1 * MiB;
constexpr size_t WS_WIN = 2 * MiB, WS_WK = 25 * MiB, WS_WV = 27 * MiB, WS_WB = 29 * MiB, WS_WO = 35 * MiB, WS_WRF = 37 * MiB, WS_COEF = 37 * MiB + 512 * 1024;
constexpr size_t WS_MN = 38 * MiB, WS_MK = 42 * MiB, WS_MVT = 46 * MiB, WS_CB = 50 * MiB, WS_AGG = 54 * MiB, WS_SSP = 56 * MiB;
constexpr size_t WS_XN = 60 * MiB, WS_OUTB = 188 * MiB, WS_Z = 316 * MiB, WS_STASH = 668 * MiB, WS_MRG = 732 * MiB, WS_END = 796 * MiB;
static_assert(WS_WIN + (size_t)NIN * D * 2 <= WS_WK && WS_SSP + (size_t)MTOK * 16 * 4 <= WS_XN && WS_XN + (size_t)MTOK * D * 2 <= WS_OUTB && WS_OUTB + (size_t)MTOK * D * 2 <= WS_Z && WS_Z + (size_t)MC * NZC * 2 <= WS_END, "d_ws map");
constexpr int CW_BAR = 4096, CW_Q = 12288, CW_NRM = 16384;

constexpr int RING_OFF = 0, RING_BYTES = 131072;
constexpr int LDSCTL_OFF = RING_BYTES, MISC_OFF = LDSCTL_OFF + 320, XS_OFF = LDSCTL_OFF + 1024;
constexpr int LDS_BYTES = 147456;
static_assert(XS_OFF + 8192 <= LDS_BYTES && attn_body::ATTN_LDS_BYTES <= RING_BYTES, "LDS map");

#define GAS __attribute__((address_space(1)))
#define LAS __attribute__((address_space(3)))
typedef unsigned short bf16;
typedef unsigned v4u __attribute__((ext_vector_type(4)));
typedef unsigned v2u __attribute__((ext_vector_type(2)));
typedef float f32x4 __attribute__((ext_vector_type(4)));
typedef float f32x16 __attribute__((ext_vector_type(16)));
typedef short bf16x8 __attribute__((ext_vector_type(8)));
typedef GAS unsigned gu32;
#define LDS_WAIT() asm volatile("s_waitcnt lgkmcnt(0)" ::: "memory")
#define VM_WAIT() asm volatile("s_waitcnt vmcnt(0)" ::: "memory")
__device__ __forceinline__ unsigned f2bf(float f) { unsigned u = __builtin_bit_cast(unsigned, f); return (u + 0x7fffu + ((u >> 16) & 1u)) >> 16; }
__device__ __forceinline__ unsigned pk2(float lo, float hi) { return f2bf(lo) | (f2bf(hi) << 16); }

#define XB_TMO      128
#define XB_XCNT(j)  (256  + 64 * (j))
#define XB_XSUB(j)  (1280 + 64 * (j))
#define XB_XGEN(j)  (2304 + 64 * (j))
#define XB_TOP      3328
#define XB_TOPGEN   3392
#define XCD_BAR_WORDS 3456
#define XB_SPIN_CAP (1u << 22)
__device__ __forceinline__ unsigned xb_ld(unsigned* p)              { return __hip_atomic_load(p, __ATOMIC_RELAXED, __HIP_MEMORY_SCOPE_AGENT); }
__device__ __forceinline__ unsigned xb_add(unsigned* p, unsigned v) { return __hip_atomic_fetch_add(p, v, __ATOMIC_RELAXED, __HIP_MEMORY_SCOPE_AGENT); }
__device__ __forceinline__ unsigned xb_xcc_id() { return (unsigned)__builtin_amdgcn_s_getreg((3 << 11) | 20) & 0xFu; }
#define XB_SPIN(cond, bar) do { unsigned _sp = 0; while (cond) { __builtin_amdgcn_s_sleep(1); \
    if ((++_sp & 255u) == 0u) { if (xb_ld(&(bar)[XB_TMO])) break; if (_sp > XB_SPIN_CAP) { atomicAdd(&(bar)[XB_TMO], 1u); break; } } } } while (0)
struct XcdBarrier { unsigned* bar; unsigned x; volatile LAS unsigned* st; };
__device__ __forceinline__ XcdBarrier xcd_barrier_post(unsigned* bar, volatile LAS unsigned* st) {
    XcdBarrier b; b.bar = bar; b.x = xb_xcc_id(); b.st = st;
    if (threadIdx.x == 0) (void)xb_add(&bar[XB_XCNT(b.x)], 1u);
    return b;
}
__device__ __forceinline__ void xcd_barrier_complete(unsigned* bar, unsigned x, unsigned& nloc, unsigned& nx) {
    const unsigned G = gridDim.x * gridDim.y * gridDim.z;
    unsigned sum, cnt, mine, sp = 0u;
    for (;;) {
        sum = 0u; cnt = 0u; mine = 0u;
#pragma unroll
        for (unsigned j = 0; j < 16; ++j) { const unsigned c = xb_ld(&bar[XB_XCNT(j)]); sum += c; cnt += (c > 0u) ? 1u : 0u; mine = (j == x) ? c : mine; }
        if (sum == G) break;
        __builtin_amdgcn_s_sleep(1);
        if ((++sp & 255u) == 0u) { if (xb_ld(&bar[XB_TMO])) break; if (sp > XB_SPIN_CAP) { atomicAdd(&bar[XB_TMO], 1u); break; } }
    }
    nloc = mine > 0u ? mine : 1u; nx = cnt > 0u ? cnt : 1u;
}
__device__ __forceinline__ void xcd_barrier(const XcdBarrier& b) {
    asm volatile("s_waitcnt vmcnt(0)" ::: "memory");
    __syncthreads();
    if (threadIdx.x == 0) {
        unsigned* bar = b.bar;
        __builtin_amdgcn_s_waitcnt(0);
        unsigned nloc = b.st[0], nx = b.st[1];
        if (nloc == 0u) { xcd_barrier_complete(bar, b.x, nloc, nx); b.st[0] = nloc; b.st[1] = nx; }
        const unsigned old = xb_add(&bar[XB_XSUB(b.x)], 1u);
        const unsigned gen = old / nloc;
        if (old + 1u == (gen + 1u) * nloc) {
            __builtin_amdgcn_fence(__ATOMIC_RELEASE, "agent");
            asm volatile("s_waitcnt vmcnt(0)" ::: "memory");
            const unsigned og = xb_add(&bar[XB_TOP], 1u);
            const unsigned tg = og / nx;
            if (og + 1u == (tg + 1u) * nx) xb_add(&bar[XB_TOPGEN], 1u);
            else XB_SPIN(xb_ld(&bar[XB_TOPGEN]) == tg, bar);
            __builtin_amdgcn_fence(__ATOMIC_ACQUIRE, "agent");
            xb_add(&bar[XB_XGEN(b.x)], 1u);
            asm volatile("s_waitcnt vmcnt(0)" ::: "memory");
        } else {
            XB_SPIN(xb_ld(&bar[XB_XGEN(b.x)]) == gen, bar);
            __builtin_amdgcn_fence(__ATOMIC_ACQUIRE, "agent");
            asm volatile("s_waitcnt vmcnt(0)" ::: "memory");
        }
    }
    __syncthreads();
}

template <class T_> __device__ __forceinline__ T_* as_global(T_* p) { return (T_*)(GAS T_*)p; }
struct Args {
    const float *x, *mem, *g_pre, *w_in, *conv_w, *conv_b, *w_lru_r, *b_lru_r, *w_lru_i, *b_lru_i, *lru_lambda, *b_forget, *g_mem, *w_mem_k, *w_mem_v, *w_branch, *b_merge, *w_out, *g_post;
    float* out; unsigned char* ws;
};

__device__ __forceinline__ float wave_sum(float v, int lane) {
#pragma unroll
    for (int o = 1; o < 64; o <<= 1) v += __builtin_bit_cast(float, __builtin_amdgcn_ds_bpermute((lane ^ o) << 2, __builtin_bit_cast(int, v)));
    return v;
}
__device__ __forceinline__ void p0_transpose_item(const float* W, int ld, int K, int ncols, bf16* WT, LAS float* scr, int item, int lane) {
    const int nblk = ncols / 32, kb = item / nblk, nb = item % nblk, k0 = 64 * kb, n0 = 32 * nb;
#pragma unroll 8
    for (int i = 0; i < 32; ++i) { const int kk = 2 * i + (lane >> 5); scr[kk * 33 + (lane & 31)] = W[(size_t)(k0 + kk) * ld + n0 + (lane & 31)]; }
    LDS_WAIT(); asm volatile("" ::: "memory");
    const int c = lane & 7;
#pragma unroll
    for (int j = 0; j < 4; ++j) { const int n = (lane >> 3) + 8 * j; const LAS float* s = scr + (8 * c) * 33 + n;
        v4u o; o.x = pk2(s[0 * 33], s[1 * 33]); o.y = pk2(s[2 * 33], s[3 * 33]); o.z = pk2(s[4 * 33], s[5 * 33]); o.w = pk2(s[6 * 33], s[7 * 33]);
        *(GAS v4u*)(WT + (size_t)(n0 + n) * K + k0 + 8 * c) = o; }
    LDS_WAIT(); asm volatile("" ::: "memory");
}
__device__ __forceinline__ void rms_row_to_bf16(const float* xrow, const float* g, bf16* orow, int lane) {
    const GAS f32x4* xr = (const GAS f32x4*)xrow + lane; const GAS f32x4* gr = (const GAS f32x4*)g + lane;
    f32x4 v[4]; float s = 0.f;
#pragma unroll
    for (int j = 0; j < 4; ++j) { v[j] = xr[64 * j]; s += (v[j].x * v[j].x + v[j].y * v[j].y) + (v[j].z * v[j].z + v[j].w * v[j].w); }
    const float rs = 1.f / sqrtf(wave_sum(s, lane) * (1.f / D) + RMS_EPS);
    GAS unsigned long long* o8 = (GAS unsigned long long*)orow + lane;
#pragma unroll
    for (int j = 0; j < 4; ++j) { const f32x4 gg = gr[64 * j];
        o8[64 * j] = (unsigned long long)pk2(v[j].x * rs * gg.x, v[j].y * rs * gg.y) | ((unsigned long long)pk2(v[j].z * rs * gg.z, v[j].w * rs * gg.w) << 32); }
}

__device__ __forceinline__ void rms_rows4_to_bf16(const float* xrow, const float* g, bf16* orow, int lane) {
    const GAS f32x4* xr = (const GAS f32x4*)xrow + lane; const GAS f32x4* gr = (const GAS f32x4*)g + lane;
    f32x4 v[4][4]; float s[4] = {0.f, 0.f, 0.f, 0.f};
#pragma unroll
    for (int r = 0; r < 4; ++r)
#pragma unroll
        for (int j = 0; j < 4; ++j) v[r][j] = xr[r * (D / 4) + 64 * j];
#pragma unroll
    for (int r = 0; r < 4; ++r)
#pragma unroll
        for (int j = 0; j < 4; ++j) s[r] += (v[r][j].x * v[r][j].x + v[r][j].y * v[r][j].y) + (v[r][j].z * v[r][j].z + v[r][j].w * v[r][j].w);
#pragma unroll
    for (int r = 0; r < 4; ++r) { const float rs = 1.f / sqrtf(wave_sum(s[r], lane) * (1.f / D) + RMS_EPS);
        GAS unsigned long long* o8 = (GAS unsigned long long*)(orow + (size_t)r * D) + lane;
#pragma unroll
        for (int j = 0; j < 4; ++j) { const f32x4 gg = gr[64 * j];
            o8[64 * j] = (unsigned long long)pk2(v[r][j].x * rs * gg.x, v[r][j].y * rs * gg.y) | ((unsigned long long)pk2(v[r][j].z * rs * gg.z, v[r][j].w * rs * gg.w) << 32); } }
}
struct LruPtrs { const float *conv_w, *conv_b, *b_lru_r, *b_lru_i; unsigned char* ws; };
template <int PASS>
__device__ __forceinline__ void lru_unit(const LruPtrs& args, LAS unsigned char* lds, int chunk, int bl, int g, int ck) {
    int tid_ = threadIdx.x; asm volatile("" : "+v"(tid_));
    const int tid = tid_, lane = tid & 63, n = lane & 31, hi = lane >> 5; const int w = __builtin_amdgcn_readfirstlane(tid >> 6);
    unsigned char* ws = args.ws; asm volatile("" : "+s"(ws)); ws = as_global(ws);
    GAS bf16* Z = (GAS bf16*)(ws + WS_Z);
    GAS float* AGG = (GAS float*)(ws + WS_AGG);
    GAS v4u* stash = (GAS v4u*)(ws + WS_STASH) + ((size_t)((bl * 16 + g) * 32 + ck) * NWAVES + w) * 8 * 64 + lane;
    LAS float* WAG = (LAS float*)(lds + RING_OFF);
    LAS float* PART = (LAS float*)(lds + RING_OFF + 4096);
    LAS float* CARW = (LAS float*)(lds + RING_OFF + 8192);
    LAS float* PRM = (LAS float*)(lds + RING_OFF + 12288);
    const int tl = ck * 256 + w * 32 + n;
    const size_t zr = (size_t)bl * T + tl;
    const int cb0 = g * 64 + 4 * hi;
    float av[8][4], uv[8][4]; v4u gtile[4]; unsigned gagg[8];
    if (PASS == 1) {
        { const float* src = (w < 4) ? args.conv_w + w * D : (w == 4) ? args.conv_b : (w == 5) ? args.b_lru_r : (w == 6) ? args.b_lru_i : (const float*)(ws + WS_COEF);
          PRM[w * 64 + lane] = ((const GAS float*)src)[g * 64 + lane]; }
        LAS bf16* XT = (LAS bf16*)(lds + RING_OFF + 32768 + w * 4864);
        {
            const int tl0 = ck * 256 + w * 32;
            v4u xv[5];
#pragma unroll
            for (int i = 0; i < 5; ++i) { const int idx = lane + 64 * i, r = idx >> 3, ch = idx & 7; const int ts = tl0 - 3 + r;
                xv[i] = (v4u){0u, 0u, 0u, 0u};
                if (r < 35 && ts >= 0) xv[i] = *(const GAS v4u*)(Z + ((size_t)bl * T + ts) * LDZ + ZC_AX + g * 64 + ch * 8); }
#pragma unroll
            for (int i = 0; i < 5; ++i) { const int idx = lane + 64 * i, r = idx >> 3, ch = idx & 7;
                if (r < 35) { *(LAS v2u*)(XT + r * 68 + ch * 8) = (v2u){xv[i].x, xv[i].y}; *(LAS v2u*)(XT + r * 68 + ch * 8 + 4) = (v2u){xv[i].z, xv[i].w}; } }
        }
        __syncthreads();
        v2u xw[4][8];
#pragma unroll
        for (int k = 0; k < 4; ++k)
#pragma unroll
            for (int q = 0; q < 8; ++q) xw[k][q] = *(const LAS v2u*)(XT + (n + k) * 68 + 8 * q + 4 * hi);
        float xc[8][4];
#pragma unroll
        for (int q = 0; q < 8; ++q) { const f32x4 bb = *(const LAS f32x4*)(PRM + 4 * 64 + 8 * q + 4 * hi);
#pragma unroll
            for (int p = 0; p < 4; ++p) xc[q][p] = bb[p]; }
#pragma unroll
        for (int k = 0; k < 4; ++k) {
#pragma unroll
            for (int q = 0; q < 8; ++q) { const f32x4 cw = *(const LAS f32x4*)(PRM + k * 64 + 8 * q + 4 * hi);
                xc[q][0] += cw[0] * pg8::bf_lo(xw[k][q].x); xc[q][1] += cw[1] * pg8::bf_hi(xw[k][q].x); xc[q][2] += cw[2] * pg8::bf_lo(xw[k][q].y); xc[q][3] += cw[3] * pg8::bf_hi(xw[k][q].y); }
        }
        f32x16 ar[2], ai_[2];
#pragma unroll
        for (int rb = 0; rb < 2; ++rb) { ar[rb] = f32x16{}; ai_[rb] = f32x16{}; }
        const GAS bf16* wrf = (const GAS bf16*)(ws + WS_WRF) + (size_t)g * (2 * 2 * 4 * 64 * 8) + lane * 8;
#pragma unroll
        for (int ks = 0; ks < 4; ++ks) {
            v4u bw; bw.x = pg8::cvt_pk_bf16(xc[2 * ks][0], xc[2 * ks][1]); bw.y = pg8::cvt_pk_bf16(xc[2 * ks][2], xc[2 * ks][3]); bw.z = pg8::cvt_pk_bf16(xc[2 * ks + 1][0], xc[2 * ks + 1][1]); bw.w = pg8::cvt_pk_bf16(xc[2 * ks + 1][2], xc[2 * ks + 1][3]);
            const bf16x8 bfr = __builtin_bit_cast(bf16x8, bw);
#pragma unroll
            for (int rb = 0; rb < 2; ++rb) {
                const bf16x8 wr_ = __builtin_bit_cast(bf16x8, *(const GAS v4u*)(wrf + ((0 * 2 + rb) * 4 + ks) * 512));
                const bf16x8 wi_ = __builtin_bit_cast(bf16x8, *(const GAS v4u*)(wrf + ((1 * 2 + rb) * 4 + ks) * 512));
                ar[rb] = __builtin_amdgcn_mfma_f32_32x32x16_bf16(wr_, bfr, ar[rb], 0, 0, 0);
                ai_[rb] = __builtin_amdgcn_mfma_f32_32x32x16_bf16(wi_, bfr, ai_[rb], 0, 0, 0);
            }
        }
#pragma unroll
        for (int q = 0; q < 8; ++q) {
            const f32x4 br = *(const LAS f32x4*)(PRM + 5 * 64 + 8 * q + 4 * hi), bi = *(const LAS f32x4*)(PRM + 6 * 64 + 8 * q + 4 * hi), cf = *(const LAS f32x4*)(PRM + 7 * 64 + 8 * q + 4 * hi);
#pragma unroll
            for (int p = 0; p < 4; ++p) { const int rb = q >> 2, r = (q & 3) * 4 + p;
                const float rr = pg8::sigm(ar[rb][r] + br[p]), ii = pg8::sigm(ai_[rb][r] + bi[p]);
                const float a0 = __builtin_amdgcn_exp2f(cf[p] * rr);
                av[q][p] = a0; uv[q][p] = __builtin_amdgcn_sqrtf(fmaxf(1.f - a0 * a0, 0.f)) * (ii * xc[q][p]); }
        }
    } else {
#pragma unroll
        for (int i = 0; i < 4; ++i) { const int idx = lane + 64 * i, r = idx >> 3, ch = idx & 7;
            gtile[i] = *(const GAS v4u*)(Z + ((size_t)bl * T + ck * 256 + w * 32 + r) * LDZ + ZC_GA + g * 64 + ch * 8); }
#pragma unroll
        for (int q = 0; q < 8; ++q) { const v4u st = stash[q * 64];
#pragma unroll
            for (int p = 0; p < 4; ++p) { av[q][p] = pg8::bf_lo(st[p]); uv[q][p] = pg8::bf_hi(st[p]); } }
        if (w == 0) { const GAS unsigned* gs = (const GAS unsigned*)((GAS v4u*)(ws + WS_STASH) + ((size_t)((bl * 16 + g) * 32 + ck) * NWAVES) * 8 * 64);
#pragma unroll
            for (int ww = 0; ww < 8; ++ww) gagg[ww] = gs[(size_t)((ww * 8 + (lane >> 3)) * 64 + 31 + 32 * ((lane >> 2) & 1)) * 4 + (lane & 3)]; }
    }
    float pA = 1.f, pH = 0.f;
    if (PASS == 3) { typedef float f32x2v __attribute__((ext_vector_type(2))); f32x2v ag[4];
#pragma unroll
        for (int j = 0; j < 4; ++j) { const int cc = 4 * w + j; ag[j] = (f32x2v){1.f, 0.f}; if (cc < ck) ag[j] = *(const GAS f32x2v*)(AGG + ((size_t)(bl * 32 + cc) * D + g * 64 + lane) * 2); }
#pragma unroll
        for (int j = 0; j < 4; ++j) { pH = ag[j].x * pH + ag[j].y; pA = pA * ag[j].x; } }
#define LRU_STEP(CTRL) \
        "v_fmac_f32_dpp %0, %0, %1 " CTRL "\n\tv_fmac_f32_dpp %2, %2, %3 " CTRL "\n\tv_fmac_f32_dpp %4, %4, %5 " CTRL "\n\tv_fmac_f32_dpp %6, %6, %7 " CTRL "\n\t" \
        "v_mul_f32_dpp %1, %1, %1 " CTRL "\n\tv_mul_f32_dpp %3, %3, %3 " CTRL "\n\tv_mul_f32_dpp %5, %5, %5 " CTRL "\n\tv_mul_f32_dpp %7, %7, %7 " CTRL "\n\t"
    if (PASS == 1) {
#pragma unroll
    for (int q = 0; q < 8; ++q)
        asm volatile("s_nop 1\n\t"
            LRU_STEP("row_shr:1 row_mask:0xf bank_mask:0xf") LRU_STEP("row_shr:2 row_mask:0xf bank_mask:0xf") LRU_STEP("row_shr:4 row_mask:0xf bank_mask:0xf")
            LRU_STEP("row_shr:8 row_mask:0xf bank_mask:0xf") LRU_STEP("row_bcast:15 row_mask:0xa bank_mask:0xf")
            : "+v"(uv[q][0]), "+v"(av[q][0]), "+v"(uv[q][1]), "+v"(av[q][1]), "+v"(uv[q][2]), "+v"(av[q][2]), "+v"(uv[q][3]), "+v"(av[q][3]));
#pragma unroll
    for (int q = 0; q < 8; ++q) { v4u st;
#pragma unroll
        for (int p = 0; p < 4; ++p) st[p] = pg8::cvt_pk_bf16(av[q][p], uv[q][p]);
        stash[q * 64] = st; }
    }
#undef LRU_STEP
    if (PASS == 1 && n == 31) {
#pragma unroll
        for (int q = 0; q < 8; ++q)
#pragma unroll
            for (int p = 0; p < 4; ++p) { const int ci = 8 * q + 4 * hi + p; WAG[(w * 64 + ci) * 2] = av[q][p]; WAG[(w * 64 + ci) * 2 + 1] = uv[q][p]; }
    }
    if (PASS == 3) { PART[(w * 64 + lane) * 2] = pA; PART[(w * 64 + lane) * 2 + 1] = pH; }
    __syncthreads();
    if (PASS == 1) {
        if (w == 0) { float A = 1.f, H = 0.f;
#pragma unroll
            for (int ww = 0; ww < 8; ++ww) { const float a = WAG[(ww * 64 + lane) * 2], h = WAG[(ww * 64 + lane) * 2 + 1]; H = a * H + h; A = A * a; }
            GAS float* dst = AGG + ((size_t)(bl * 32 + ck) * D + g * 64 + lane) * 2; dst[0] = A; dst[1] = H; }
        __syncthreads();
    } else {
        if (w == 0) { float H = 0.f;
#pragma unroll
            for (int ww = 0; ww < 8; ++ww) H = PART[(ww * 64 + lane) * 2] * H + PART[(ww * 64 + lane) * 2 + 1];
#pragma unroll
            for (int ww = 0; ww < 8; ++ww) { CARW[ww * 64 + lane] = H; H = pg8::bf_lo(gagg[ww]) * H + pg8::bf_hi(gagg[ww]); } }
        __syncthreads();
        LAS bf16* GT = (LAS bf16*)(lds + RING_OFF + 32768 + w * 4864);
#pragma unroll
        for (int i = 0; i < 4; ++i) { const int idx = lane + 64 * i, r = idx >> 3, ch = idx & 7;
            *(LAS v2u*)(GT + r * 68 + ch * 8) = (v2u){gtile[i].x, gtile[i].y}; *(LAS v2u*)(GT + r * 68 + ch * 8 + 4) = (v2u){gtile[i].z, gtile[i].w}; }
        asm volatile("s_waitcnt lgkmcnt(0)" ::: "memory");
#pragma unroll
        for (int q = 0; q < 8; ++q) { const f32x4 cr = *(const LAS f32x4*)(CARW + w * 64 + 8 * q + 4 * hi);
            LAS v2u* gl = (LAS v2u*)(GT + n * 68 + 8 * q + 4 * hi);
            const v2u gw = *gl;
            const float h0 = (uv[q][0] + av[q][0] * cr[0]) * pg8::bf_lo(gw.x), h1 = (uv[q][1] + av[q][1] * cr[1]) * pg8::bf_hi(gw.x);
            const float h2 = (uv[q][2] + av[q][2] * cr[2]) * pg8::bf_lo(gw.y), h3 = (uv[q][3] + av[q][3] * cr[3]) * pg8::bf_hi(gw.y);
            v2u o; o.x = pg8::cvt_pk_bf16(h0, h1); o.y = pg8::cvt_pk_bf16(h2, h3); *gl = o; }
        asm volatile("s_waitcnt lgkmcnt(0)" ::: "memory");
#pragma unroll
        for (int i = 0; i < 4; ++i) { const int idx = lane + 64 * i, r = idx >> 3, ch = idx & 7;
            const v2u a = *(const LAS v2u*)(GT + r * 68 + ch * 8), b = *(const LAS v2u*)(GT + r * 68 + ch * 8 + 4);
            *(GAS v4u*)(Z + ((size_t)bl * T + ck * 256 + w * 32 + r) * LDZ + ZC_GA + g * 64 + ch * 8) = (v4u){a.x, a.y, b.x, b.y}; }
        __syncthreads();
    }
}

__device__ __forceinline__ void cumsum_unit(float* CBh, LAS unsigned char* lds) {
    int tid_ = threadIdx.x; asm volatile("" : "+v"(tid_));
    const int tid = tid_, lane = tid & 63, w = tid >> 6;
    LAS float* wsum = (LAS float*)(lds + RING_OFF + 16384);
    f32x4 v[4]; float s = 0.f;
#pragma unroll
    for (int j = 0; j < 4; ++j) { v[j] = *(const f32x4*)(CBh + tid * 16 + 4 * j);
#pragma unroll
        for (int e = 0; e < 4; ++e) { s += v[j][e]; v[j][e] = s; } }
    float inc = s;
#pragma unroll
    for (int d = 1; d < 64; d <<= 1) { const float o = __builtin_bit_cast(float, __builtin_amdgcn_ds_bpermute((lane - d) << 2, __builtin_bit_cast(int, inc))); if (lane >= d) inc += o; }
    if (lane == 63) wsum[w] = inc;
    __syncthreads();
    float off = inc - s;
    for (int ww = 0; ww < w; ++ww) off += wsum[ww];
#pragma unroll
    for (int j = 0; j < 4; ++j) { f32x4 o;
#pragma unroll
        for (int e = 0; e < 4; ++e) o[e] = -(off + v[j][e]) * LOG2E;
        *(f32x4*)(CBh + tid * 16 + 4 * j) = o; }
    __syncthreads();
}

struct SchedIn { pg8::TileOrder o; const bf16* XNc; const bf16* WinT; bf16* Z;
    __device__ __forceinline__ bool next(int i, pg8::Unit& u) const { int pm, pn; if (!o.map(i, pm, pn)) return false; u.pm = pm; u.pn = pn; u.z = 0; u.ldo = LDZ;
        u.A = XNc + (size_t)pm * 256 * D; u.B = WinT + (size_t)pn * 256 * D; u.O = Z + (size_t)(pn >> 2) * ZBLK + (size_t)pm * 256 * LDZ + (pn & 3) * 256; u.G = nullptr; return true; } };
struct SchedMemKV { int q; const bf16 *MN, *WkT, *WvT; bf16 *MK, *MVT;
    __device__ __forceinline__ bool next(int i, pg8::Unit& u) const { if (i > 0 || q < 0 || q >= 64) return false; u.z = 0; u.G = nullptr;
        if (q < 32) { const int pm = q >> 2, pn = q & 3; u.pm = pm; u.pn = pn; u.A = MN + (size_t)pm * 256 * D; u.B = WkT + (size_t)pn * 256 * D; u.O = MK + (size_t)pm * 256 * D + pn * 256; u.ldo = D; }
        else { const int b = (q - 32) >> 2, pm = (q - 32) & 3; u.pm = pm; u.pn = 0; u.A = WvT + (size_t)pm * 256 * D; u.B = MN + (size_t)b * MEMLEN * D; u.O = MVT + (size_t)b * D * MEMLEN + (size_t)pm * 256 * MEMLEN; u.ldo = MEMLEN; }
        return true; } };
struct SchedMemS { int G, c, chunk; bf16* Z; const bf16* MK;
    __device__ __forceinline__ bool next(int i, pg8::Unit& u) const { const int L = i * G + c; if (L >= 256) return false; const int bl = L >> 7, h = (L >> 5) & 3, pmb = L & 31;
        const size_t r0 = (size_t)bl * T + pmb * 256; u.pm = pmb; u.pn = 0; u.z = 0; u.ldo = LDZ;
        u.A = Z + r0 * LDZ + ZC_MQ + h * 256; u.B = MK + (size_t)((chunk * CHB + bl) * MEMLEN) * D + h * 256; u.O = Z + r0 * LDZ + ZC_MQ + h * 256; u.G = nullptr; return true; } };
struct SchedMemPV { int G, c, chunk; bf16* Z; const bf16* MVT;
    __device__ __forceinline__ bool next(int i, pg8::Unit& u) const { const int L = i * G + c; if (L >= 256) return false; const int bl = L >> 7, h = (L >> 5) & 3, pmb = L & 31;
        const size_t r0 = (size_t)bl * T + pmb * 256; u.pm = pmb; u.pn = 0; u.z = 0; u.ldo = LDZ;
        u.A = Z + r0 * LDZ + ZC_MQ + h * 256; u.B = MVT + (size_t)(chunk * CHB + bl) * D * MEMLEN + (size_t)h * 256 * MEMLEN; u.O = Z + r0 * LDZ + ZC_MQ + h * 256; u.G = Z + r0 * LDZ + ZC_GM + h * 256; return true; } };
struct SchedMerge { pg8::TileOrder o; bf16* Z; const bf16* WBt; bf16* MRG;
    __device__ __forceinline__ bool next(int i, pg8::Unit& u) const { int pm, pn; if (!o.map(i / 3, pm, pn)) return false; const int nb = i % 3; u.pm = pm; u.pn = pn; u.z = nb; u.ldo = LDZ;
        const size_t acol = nb == 0 ? ZC_GA : nb == 1 ? ZC_Q : ZC_MQ;
        u.A = Z + (size_t)pm * 256 * LDZ + acol; u.B = WBt + (size_t)nb * D * D + (size_t)pn * 256 * D; u.O = MRG + (size_t)pm * 256 * D + pn * 256; u.ldo = D; u.G = Z + (size_t)pm * 256 * LDZ + ZC_MG + (size_t)nb * ZBLK + pn * 256; return true; } };
struct SchedOut { pg8::TileOrder o; const bf16* MRG; const bf16* WoT; bf16* OUTB; int chunk;
    __device__ __forceinline__ bool next(int i, pg8::Unit& u) const { int pm, pn; if (!o.map(i, pm, pn)) return false; u.pm = pm; u.pn = pn; u.z = chunk * MC + pm * 256; u.ldo = D;
        u.A = MRG + (size_t)pm * 256 * D; u.B = WoT + (size_t)pn * 256 * D; u.O = OUTB + (size_t)(chunk * MC + pm * 256) * D + pn * 256; u.G = nullptr; return true; } };

__global__ void __launch_bounds__(NWAVES * 64, 2) hybrid_fwd(Args args) {
    extern __shared__ __attribute__((aligned(16))) unsigned char lds_raw[];
    LAS unsigned char* lds = (LAS unsigned char*)lds_raw;
    volatile LAS unsigned* MISC = (volatile LAS unsigned*)(lds + MISC_OFF);
    const int tid = threadIdx.x, lane = tid & 63, wave = __builtin_amdgcn_readfirstlane(tid >> 6);
    const int G = gridDim.x, c = blockIdx.x;
    typedef const __attribute__((address_space(4))) Args* KArgs;
#define KA() ({ KArgs p_ = (KArgs)__builtin_amdgcn_kernarg_segment_ptr(); asm volatile("" : "+s"(p_)); p_; })
    unsigned char* ws = KA()->ws;
    gu32* ctl = (gu32*)(ws + WS_CTL);
    bf16* WinT = (bf16*)(ws + WS_WIN); bf16* WkT = (bf16*)(ws + WS_WK); bf16* WvT = (bf16*)(ws + WS_WV); bf16* WBt = (bf16*)(ws + WS_WB); bf16* WoT = (bf16*)(ws + WS_WO);
    bf16* MN = (bf16*)(ws + WS_MN); bf16* MK = (bf16*)(ws + WS_MK); bf16* MVT = (bf16*)(ws + WS_MVT);
    float* CB = (float*)(ws + WS_CB); float* SSP = (float*)(ws + WS_SSP);
    bf16* XN = (bf16*)(ws + WS_XN); bf16* OUTB = (bf16*)(ws + WS_OUTB); bf16* Z = (bf16*)(ws + WS_Z);
    for (int u = tid; u < (LDS_BYTES - LDSCTL_OFF) / 4; u += NWAVES * 64) ((LAS unsigned*)(lds + LDSCTL_OFF))[u] = 0u;
    __syncthreads();
    (void)xcd_barrier_post((unsigned*)(ctl + CW_BAR), MISC + 8);
#define GRID_BAR() do { XcdBarrier bar_; bar_.bar = (unsigned*)(KA()->ws + WS_CTL) + CW_BAR; bar_.x = xb_xcc_id(); bar_.st = MISC + 8; xcd_barrier(bar_); } while (0)

    {
        KArgs args = KA();
        LAS float* scr = (LAS float*)(lds + RING_OFF + wave * 16384);
        const int gw = c * NWAVES + wave, NGW = G * NWAVES;
        constexpr int I_A = 16 * (5120 / 32), I_B = 16 * (6144 / 32), I_S = 16 * 32;
        constexpr int NITEMS = I_A + I_B + 6 * I_S;
        for (int it = gw; it < NITEMS; it += NGW) {
            int r = it;
            if (r < I_A) { p0_transpose_item(args->w_in, IN_COLS, D, 5120, WinT, scr, r, lane); continue; } r -= I_A;
            if (r < I_B) { p0_transpose_item(args->w_in + 5136, IN_COLS, D, 6144, WinT + (size_t)5120 * D, scr, r, lane); continue; } r -= I_B;
            if (r < I_S) { p0_transpose_item(args->w_mem_k, D, D, D, WkT, scr, r, lane); continue; } r -= I_S;
            if (r < I_S) { p0_transpose_item(args->w_mem_v, D, D, D, WvT, scr, r, lane); continue; } r -= I_S;
            if (r < 3 * I_S) { const int nb = r / I_S; p0_transpose_item(args->w_branch + (size_t)nb * D * D, D, D, D, WBt + (size_t)nb * D * D, scr, r % I_S, lane); continue; } r -= 3 * I_S;
            p0_transpose_item(args->w_out, D, D, D, WoT, scr, r, lane);
        }
        const int gt = c * (NWAVES * 64) + tid, NGT = G * NWAVES * 64;
        for (int e = gt; e < 256 * 128; e += NGT) { const int row = e >> 7, k8 = (e & 127) * 8; v4u o = (v4u){0u, 0u, 0u, 0u};
            if (row < 16) { const float* s = args->w_in + (size_t)k8 * IN_COLS + 5120 + row;
                o.x = pk2(s[0], s[IN_COLS]); o.y = pk2(s[2 * IN_COLS], s[3 * IN_COLS]); o.z = pk2(s[4 * IN_COLS], s[5 * IN_COLS]); o.w = pk2(s[6 * IN_COLS], s[7 * IN_COLS]); }
            *(v4u*)(WinT + (size_t)(NZC + row) * D + k8) = o; }
        for (int e = gt; e < 16 * 2 * 2 * 4 * 64; e += NGT) { const int ln = e & 63, ks = (e >> 6) & 3, rb = (e >> 8) & 1, mat = (e >> 9) & 1, gg = e >> 10;
            const float* Wm = (mat ? args->w_lru_i : args->w_lru_r) + (size_t)gg * 64 * 64; const int j = 32 * rb + (ln & 31), hh = ln >> 5;
            float f[8];
#pragma unroll
            for (int q = 0; q < 8; ++q) { const int k = 8 * (2 * ks + (q >> 2)) + 4 * hh + (q & 3); f[q] = Wm[k * 64 + j]; }
            v4u o; o.x = pk2(f[0], f[1]); o.y = pk2(f[2], f[3]); o.z = pk2(f[4], f[5]); o.w = pk2(f[6], f[7]);
            *(v4u*)((bf16*)(ws + WS_WRF) + (size_t)e * 8) = o; }
        for (int e = gt; e < D; e += NGT) { const float x = -args->lru_lambda[e]; const float sp = fmaxf(x, 0.f) + log1pf(expf(-fabsf(x))); ((float*)(ws + WS_COEF))[e] = -8.f * sp * LOG2E; }
        { const float* xg0 = as_global(args->x); const float* gp0 = as_global(args->g_pre);
          for (int m = 4 * gw; m < MTOK; m += 4 * NGW) rms_rows4_to_bf16(xg0 + (size_t)m * D, gp0, XN + (size_t)m * D, lane); }
        for (int m = gw; m < NB * MEMLEN; m += NGW) rms_row_to_bf16(args->mem + (size_t)m * D, args->g_mem, MN + (size_t)m * D, lane);
    }
    if (gridDim.y != 1) cg::this_grid().sync();
    GRID_BAR();
    {
        KArgs args = KA(); const float* bfg = as_global(args->b_forget);
        const GAS bf16* XNg = (const GAS bf16*)(as_global(args->ws) + WS_XN); const GAS bf16* Wf = (const GAS bf16*)(as_global(args->ws) + WS_WIN) + (size_t)NZC * D;
        GAS float* LFt = (GAS float*)(as_global(args->ws) + WS_CB);
        int tid_ = threadIdx.x; asm volatile("" : "+v"(tid_)); const int ln = tid_ & 63, r32 = ln & 31, hi = ln >> 5, wv = __builtin_amdgcn_readfirstlane(tid_ >> 6);
        const bool kvcu = (G >= 192 && c >= 64 && c < 128);
        const int cc = !(G >= 192) ? c : (c < 64 ? c : c - 64), GG = (G >= 192) ? G - 64 : G;
        for (int it = kvcu ? MTOK : cc * NWAVES + wv; it < MTOK / 32; it += GG * NWAVES) {
            const GAS bf16* ap = XNg + (size_t)(it * 32 + r32) * D + 8 * hi; const GAS bf16* bp = Wf + (size_t)r32 * D + 8 * hi;
            f32x16 acc = f32x16{};
#pragma unroll 8
            for (int ks = 0; ks < 64; ++ks) { const bf16x8 af = __builtin_bit_cast(bf16x8, *(const GAS v4u*)(ap + 16 * ks)), bfv = __builtin_bit_cast(bf16x8, *(const GAS v4u*)(bp + 16 * ks));
                acc = __builtin_amdgcn_mfma_f32_32x32x16_bf16(af, bfv, acc, 0, 0, 0); }
            if (r32 < 16) { const float bb = bfg[r32]; const int tok = it * 32, bg = tok >> 13, t = tok & (T - 1);
#pragma unroll
                for (int g4 = 0; g4 < 4; ++g4) { f32x4 o;
#pragma unroll
                    for (int e = 0; e < 4; ++e) { const float x = acc[4 * g4 + e] + bb; o[e] = fminf(x, 0.f) - log1pf(__expf(-fabsf(x))); }
                    *(GAS f32x4*)(LFt + (size_t)(bg * 16 + r32) * T + t + 8 * g4 + 4 * hi) = o; } }
        }
        {
            unsigned char* wsk = as_global(args->ws);
            pg8::Gemm g{D, D, D}; SchedMemKV S2{(G >= 192) ? (kvcu ? c - 64 : -1) : ((c < 64) ? c : -1), (const bf16*)(wsk + WS_MN), (const bf16*)(wsk + WS_WK), (const bf16*)(wsk + WS_WV), (bf16*)(wsk + WS_MK), (bf16*)(wsk + WS_MVT)}; pg8::EpiStore E2;
            if (G >= 64) pg8::gemm_phase<pg8::EpiStore, SchedMemKV>(lds + RING_OFF, g, S2, E2);
        }
    }

    for (int chunk = 0; chunk < NCHUNK; ++chunk) {
        unsigned char* wsl = as_global(KA()->ws);
        int c = blockIdx.x, G = gridDim.x; asm volatile("" : "+s"(c), "+s"(G));
        bf16* WinT = (bf16*)(wsl + WS_WIN); bf16* WkT = (bf16*)(wsl + WS_WK); bf16* WvT = (bf16*)(wsl + WS_WV); bf16* WBt = (bf16*)(wsl + WS_WB); bf16* WoT = (bf16*)(wsl + WS_WO);
        bf16* MN = (bf16*)(wsl + WS_MN); bf16* MK = (bf16*)(wsl + WS_MK); bf16* MVT = (bf16*)(wsl + WS_MVT);
        float* CB = (float*)(wsl + WS_CB); float* SSP = (float*)(wsl + WS_SSP); unsigned* NRM = (unsigned*)(wsl + WS_CTL) + CW_NRM;
        bf16* XN = (bf16*)(wsl + WS_XN); bf16* OUTB = (bf16*)(wsl + WS_OUTB); bf16* Z = (bf16*)(wsl + WS_Z);
        {
            pg8::Gemm g{D, D, D}; SchedIn S; S.o.init(MC / 256, NZT, G, c); S.XNc = XN + (size_t)chunk * MC * D; S.WinT = WinT; S.Z = Z;
            pg8::EpiIn E{as_global(KA()->b_merge), chunk * MC, NRM};
            pg8::gemm_phase<pg8::EpiIn, SchedIn>(lds + RING_OFF, g, S, E);
        }
        GRID_BAR();
        {
            {
                KArgs ka = KA(); const LruPtrs lp{as_global(ka->conv_w), as_global(ka->conv_b), as_global(ka->b_lru_r), as_global(ka->b_lru_i), as_global(ka->ws)};
                unsigned* qc = (unsigned*)(wsl + WS_CTL) + CW_Q + (chunk * 2 + 0) * 64; LAS unsigned* slot = (LAS unsigned*)(lds + LDSCTL_OFF + 64);
                for (;;) {
                    if (threadIdx.x == 0) *slot = __hip_atomic_fetch_add(qc, 1u, __ATOMIC_RELAXED, __HIP_MEMORY_SCOPE_AGENT);
                    __syncthreads();
                    const int L = __builtin_amdgcn_readfirstlane((int)*slot);
                    __syncthreads();
                    if (L >= CHB * 16 * 32 + CHB * 16) break;
                    if (L >= CHB * 16) { const int L1 = L - CHB * 16; lru_unit<1>(lp, lds, chunk, L1 >> 9, (L1 >> 5) & 15, L1 & 31); }
                    else cumsum_unit(CB + (size_t)(chunk * CHB * 16 + L) * T, lds);
                }
            }
            pg8::Gemm g{LDZ, D, 256}; SchedMemS S{G, c, chunk, Z, MK}; pg8::EpiSoftmax E{(PG8_LAS float*)(lds + XS_OFF)};
            pg8::gemm_phase<pg8::EpiSoftmax, SchedMemS>(lds + RING_OFF, g, S, E);
        }
        GRID_BAR();
        {
            {
                KArgs ka = KA(); const LruPtrs lp{as_global(ka->conv_w), as_global(ka->conv_b), as_global(ka->b_lru_r), as_global(ka->b_lru_i), as_global(ka->ws)};
                unsigned* qc = (unsigned*)(wsl + WS_CTL) + CW_Q + (chunk * 2 + 1) * 64; LAS unsigned* slot = (LAS unsigned*)(lds + LDSCTL_OFF + 64);
                for (;;) {
                    if (threadIdx.x == 0) *slot = __hip_atomic_fetch_add(qc, 1u, __ATOMIC_RELAXED, __HIP_MEMORY_SCOPE_AGENT);
                    __syncthreads();
                    const int L = __builtin_amdgcn_readfirstlane((int)*slot);
                    __syncthreads();
                    if (L >= 2 * CHB * 16 * 32) break;
                    if (L < CHB * 16 * 32) { const int qb = 31 - (L >> 5), bh = L & 31;
                        attn_body::attn_unit<48>(bh / 16, bh % 16, qb, (const attn_body::bf16*)(Z + ZC_Q), (const attn_body::bf16*)(Z + ZC_K), (const attn_body::bf16*)(Z + ZC_V), (attn_body::bf16*)(Z + ZC_Q),
                                                (const attn_body::bf16*)(Z + ZC_GF), CB + (size_t)(chunk * CHB * 16 + bh) * T, NRM + (chunk * CHB * 16 + bh) * 2, NRM + 1024 + ((chunk * CHB * 16 + bh) * 32 + qb) * 2, (char*)lds_raw + RING_OFF); }
                    else { const int L3 = L - CHB * 16 * 32; lru_unit<3>(lp, lds, chunk, L3 >> 9, (L3 >> 5) & 15, L3 & 31); }
                }
            }
            pg8::Gemm g{LDZ, MEMLEN, 256}; SchedMemPV S{G, c, chunk, Z, MVT}; pg8::EpiMul E;
            pg8::gemm_phase<pg8::EpiMul, SchedMemPV>(lds + RING_OFF, g, S, E);
        }
        GRID_BAR();
        {
            pg8::Gemm g{LDZ, D, D}; SchedMerge S; S.o.init(MC / 256, D / 256, G, c); S.Z = Z; S.WBt = WBt; S.MRG = (bf16*)(wsl + WS_MRG) + (size_t)(chunk & 1) * MC * D; pg8::EpiMerge E;
            pg8::gemm_phase<pg8::EpiMerge, SchedMerge>(lds + RING_OFF, g, S, E);
        }
        GRID_BAR();
        {
            pg8::Gemm g{D, D, D}; SchedOut S; S.o.init(MC / 256, D / 256, G, c); S.MRG = (const bf16*)(wsl + WS_MRG) + (size_t)(chunk & 1) * MC * D; S.WoT = WoT; S.OUTB = OUTB; S.chunk = chunk; pg8::EpiOut E{SSP};
            pg8::gemm_phase<pg8::EpiOut, SchedOut>(lds + RING_OFF, g, S, E);
        }
        if (chunk + 1 == NCHUNK) GRID_BAR();
    }
    {
        KArgs args = KA();
        const float* SSP = (const float*)(as_global(args->ws) + WS_SSP); const bf16* OUTB = (const bf16*)(as_global(args->ws) + WS_OUTB);
        const float* xg_ = as_global(args->x); const float* gpost_ = as_global(args->g_post); float* outg_ = as_global(args->out);
        int tid_ = threadIdx.x; asm volatile("" : "+v"(tid_)); const int lane = tid_ & 63, wave = __builtin_amdgcn_readfirstlane(tid_ >> 6);
        const int gw = c * NWAVES + wave, NGW = G * NWAVES;
        for (int m = 2 * gw; m < MTOK; m += 2 * NGW) {
            f32x4 xv[2][4]; v2u ow[2][4]; float sp[2];
#pragma unroll
            for (int r = 0; r < 2; ++r) { sp[r] = (lane < 16) ? ((const GAS float*)SSP)[(size_t)(m + r) * 16 + lane] : 0.f;
                const GAS f32x4* xr = (const GAS f32x4*)(xg_ + (size_t)(m + r) * D) + lane; const GAS v2u* orow = (const GAS v2u*)(OUTB + (size_t)(m + r) * D) + lane;
#pragma unroll
                for (int j = 0; j < 4; ++j) { xv[r][j] = xr[64 * j]; ow[r][j] = orow[64 * j]; } }
#pragma unroll
            for (int r = 0; r < 2; ++r) { const float rs = 1.f / sqrtf(wave_sum(sp[r], lane) * (1.f / D) + RMS_EPS);
                const GAS f32x4* gr = (const GAS f32x4*)gpost_ + lane; GAS f32x4* yr = (GAS f32x4*)(outg_ + (size_t)(m + r) * D) + lane;
#pragma unroll
                for (int j = 0; j < 4; ++j) { const f32x4 gg = gr[64 * j]; f32x4 y;
                    y.x = xv[r][j].x + pg8::bf_lo(ow[r][j].x) * rs * gg.x; y.y = xv[r][j].y + pg8::bf_hi(ow[r][j].x) * rs * gg.y; y.z = xv[r][j].z + pg8::bf_lo(ow[r][j].y) * rs * gg.z; y.w = xv[r][j].w + pg8::bf_hi(ow[r][j].y) * rs * gg.w;
                    __builtin_nontemporal_store(y, &yr[64 * j]); } }
        }
    }
#undef GRID_BAR
#undef KA
}

extern "C" void kernel_launch(void* const* d_in, const int* in_sizes, int n_in, void* d_out, int out_size, void* d_ws, size_t ws_size, hipStream_t stream) {
    static int grid = 0;
    if (grid == 0) {
        if (n_in != 19 || in_sizes[0] != MTOK * D || out_size != MTOK * D || ws_size < WS_END) { fprintf(stderr, "kernel_launch: unexpected shapes (n_in %d, in0 %d, out %d, ws %zu); nothing launched\n", n_in, n_in > 0 ? in_sizes[0] : -1, out_size, ws_size); grid = -1; return; }
        int dev = 0, cus = 0, per_cu = 0;
        if (hipGetDevice(&dev) != hipSuccess || hipDeviceGetAttribute(&cus, hipDeviceAttributeMultiprocessorCount, dev) != hipSuccess) { grid = -1; return; }
        if (hipFuncSetAttribute((const void*)hybrid_fwd, hipFuncAttributeMaxDynamicSharedMemorySize, LDS_BYTES) != hipSuccess) { fprintf(stderr, "kernel_launch: hipFuncSetAttribute failed\n"); grid = -1; return; }
        if (hipOccupancyMaxActiveBlocksPerMultiprocessor(&per_cu, (const void*)hybrid_fwd, NWAVES * 64, LDS_BYTES) != hipSuccess || per_cu < 1) { fprintf(stderr, "kernel_launch: occupancy query reports %d\n", per_cu); per_cu = 1; }
        (void)hipGetLastError();
        grid = cus;
    }
    if (grid < 0) return;
    if (hipMemsetAsync((char*)d_ws + WS_CTL, 0, CTL_ZERO_BYTES, stream) != hipSuccess) { fprintf(stderr, "kernel_launch: hipMemsetAsync failed\n"); return; }
    Args a{};
    a.x = (const float*)d_in[0]; a.mem = (const float*)d_in[1]; a.g_pre = (const float*)d_in[2]; a.w_in = (const float*)d_in[3]; a.conv_w = (const float*)d_in[4]; a.conv_b = (const float*)d_in[5];
    a.w_lru_r = (const float*)d_in[6]; a.b_lru_r = (const float*)d_in[7]; a.w_lru_i = (const float*)d_in[8]; a.b_lru_i = (const float*)d_in[9]; a.lru_lambda = (const float*)d_in[10]; a.b_forget = (const float*)d_in[11];
    a.g_mem = (const float*)d_in[12]; a.w_mem_k = (const float*)d_in[13]; a.w_mem_v = (const float*)d_in[14]; a.w_branch = (const float*)d_in[15]; a.b_merge = (const float*)d_in[16]; a.w_out = (const float*)d_in[17]; a.g_post = (const float*)d_in[18];
    a.out = (float*)d_out; a.ws = (unsigned char*)d_ws;
    void* kargs[] = {&a};
    const hipError_t le = hipLaunchCooperativeKernel((const void*)hybrid_fwd, dim3(grid), dim3(NWAVES * 64), kargs, LDS_BYTES, stream);
    if (le != hipSuccess) fprintf(stderr, "kernel_launch: cooperative launch failed: %s (grid %d)\n", hipGetErrorName(le), grid);
}
```
